# Optimizing an MI355X kernel written in HIP

```python
import math
import jax, jax.numpy as jnp
from jax import lax
import numpy as np

D_MODEL = 1024
BATCH = 8
SEQ = 4096
DEPTH = 2

N_MIXERS = 2
EXPAND = 2
BRANCH = EXPAND * D_MODEL
EPS = 1e-6

DA_HEAD = 64
DA_HEADS = BRANCH // (2 * DA_HEAD)
DA_VDIM = 2 * DA_HEAD
Q_BLOCK = 128

S5_GROUP = 16
S5_GROUPS = BRANCH // S5_GROUP
S5_STATE = 64
S5_CHUNK = 128
DT_MIN = 1e-3
DT_MAX = 1e-1

kernel_name = "hybrid_diffattn_s5_gated"


def rms_norm(x, g):
    xf = x.astype(jnp.float32)
    y = xf * lax.rsqrt(jnp.mean(xf * xf, axis=-1, keepdims=True) + EPS)
    return (y * g.astype(jnp.float32)).astype(x.dtype)


def alibi_slopes(n_heads):
    return jnp.asarray(2.0 ** (-8.0 * np.arange(1, n_heads + 1) / n_heads), dtype=jnp.float32)


def lambda_init(layer_idx):
    return 0.8 - 0.6 * math.exp(-0.3 * layer_idx)


def diff_attention_layer(x, norm_g, w_in, q_norm_g, k_norm_g, lam_q1, lam_k1,
                         lam_q2, lam_k2, head_norm_g, w_out, layer_idx):
    b, s, _ = x.shape
    h = rms_norm(x, norm_g)
    q, k, v, z = jnp.split(h @ w_in, 4, axis=-1)
    q = rms_norm(q.reshape(b, s, DA_HEADS, 2, DA_HEAD), q_norm_g) * (DA_HEAD ** -0.5)
    k = rms_norm(k.reshape(b, s, DA_HEADS, 2, DA_HEAD), k_norm_g)
    v = v.reshape(b, s, DA_HEADS, DA_VDIM)

    f32 = jnp.float32
    lam_0 = lambda_init(layer_idx)
    lam = (jnp.exp(jnp.sum(lam_q1.astype(f32) * lam_k1.astype(f32)))
           - jnp.exp(jnp.sum(lam_q2.astype(f32) * lam_k2.astype(f32))) + lam_0)
    slopes = alibi_slopes(DA_HEADS)

    outs = []
    for blk in range(s // Q_BLOCK):
        q0 = blk * Q_BLOCK
        kv_len = q0 + Q_BLOCK
        qb = q[:, q0:kv_len]
        kb = k[:, :kv_len]
        vb = v[:, :kv_len]
        scores = jnp.einsum('bqhmd,bkhmd->bhmqk', qb, kb,
                            preferred_element_type=f32)
        dist = (jnp.arange(q0, kv_len)[:, None] - jnp.arange(kv_len)[None, :]).astype(f32)
        bias = jnp.where(dist >= 0, -slopes[:, None, None] * dist, -jnp.inf)
        probs = jax.nn.softmax(scores + bias[None, :, None], axis=-1)
        weights = probs[:, :, 0] - lam * probs[:, :, 1]
        outs.append(jnp.einsum('bhqk,bkhe->bqhe', weights.astype(v.dtype), vb))
    o = jnp.concatenate(outs, axis=1)
    o = rms_norm(o, head_norm_g) * (1.0 - lam_0)
    o = o.reshape(b, s, BRANCH) * jax.nn.silu(z)
    return x + o @ w_out


def _ssm_combine(e1, e2):
    a1r, a1i, b1r, b1i = e1
    a2r, a2i, b2r, b2i = e2
    return (a2r * a1r - a2i * a1i,
            a2r * a1i + a2i * a1r,
            a2r * b1r - a2i * b1i + b2r,
            a2r * b1i + a2i * b1r + b2i)


def s5_layer(x, norm_g, w_in, lam_re, lam_im, log_dt, b_re, b_im, c_re, c_im,
             d_skip, w_glu, b_glu, w_out):
    b, s, _ = x.shape
    f32 = jnp.float32
    h = rms_norm(x, norm_g)
    u, z = jnp.split(h @ w_in, 2, axis=-1)

    dt = jnp.exp(log_dt.astype(f32))[:, None]
    lr, li = lam_re.astype(f32), lam_im.astype(f32)
    mag = jnp.exp(lr * dt)
    ab_re, ab_im = mag * jnp.cos(li * dt), mag * jnp.sin(li * dt)
    den = lr * lr + li * li
    nr, ni = ab_re - 1.0, ab_im
    g_re = (nr * lr + ni * li) / den
    g_im = (ni * lr - nr * li) / den
    br, bi = b_re.astype(f32), b_im.astype(f32)
    bb_re = g_re[..., None] * br - g_im[..., None] * bi
    bb_im = g_re[..., None] * bi + g_im[..., None] * br
    cr, ci = c_re.astype(f32), c_im.astype(f32)

    n_chunks = s // S5_CHUNK
    ug = u.astype(f32).reshape(b, n_chunks, S5_CHUNK, S5_GROUPS, S5_GROUP)
    ug = jnp.moveaxis(ug, 1, 0)
    a_shape = (b, S5_CHUNK, S5_GROUPS, S5_STATE)
    a_re = jnp.broadcast_to(ab_re, a_shape)
    a_im = jnp.broadcast_to(ab_im, a_shape)

    def chunk_step(carry, u_c):
        h_re, h_im = carry
        bu_re = jnp.einsum('blgc,gpc->blgp', u_c, bb_re)
        bu_im = jnp.einsum('blgc,gpc->blgp', u_c, bb_im)
        acc_re, acc_im, st_re, st_im = lax.associative_scan(
            _ssm_combine, (a_re, a_im, bu_re, bu_im), axis=1)
        st_re = acc_re * h_re[:, None] - acc_im * h_im[:, None] + st_re
        st_im = acc_re * h_im[:, None] + acc_im * h_re[:, None] + st_im
        y = (jnp.einsum('blgp,gcp->blgc', st_re, cr)
             - jnp.einsum('blgp,gcp->blgc', st_im, ci))
        return (st_re[:, -1], st_im[:, -1]), y

    h0 = jnp.zeros((b, S5_GROUPS, S5_STATE), f32)
    _, ys = lax.scan(chunk_step, (h0, h0), ug)
    y = jnp.moveaxis(ys, 0, 1).reshape(b, s, BRANCH)
    y = y + d_skip.astype(f32) * u.astype(f32)
    y = jax.nn.gelu(y)
    y = y * jax.nn.sigmoid(y @ w_glu.astype(f32) + b_glu.astype(f32))
    y = y.astype(x.dtype) * jax.nn.silu(z)
    return x + y @ w_out


def setup_inputs(seed: int = 0) -> dict:
    key = jax.random.key(seed)
    ks = jax.random.split(key, 32)
    nrm = jax.random.normal
    f32 = jnp.float32
    D, E, G, P, C = D_MODEL, BRANCH, S5_GROUPS, S5_STATE, S5_GROUP
    inp = {}
    inp['x'] = nrm(ks[0], (BATCH, SEQ, D), f32)
    inp['l0_norm_g'] = 1.0 + 0.02 * nrm(ks[1], (D,), f32)
    inp['l0_w_in'] = nrm(ks[2], (D, 4 * E), f32) * D ** -0.5
    inp['l0_q_norm_g'] = 1.0 + 0.02 * nrm(ks[3], (DA_HEAD,), f32)
    inp['l0_k_norm_g'] = 1.0 + 0.02 * nrm(ks[4], (DA_HEAD,), f32)
    inp['l0_lam_q1'] = 0.1 * nrm(ks[5], (DA_HEAD,), f32)
    inp['l0_lam_k1'] = 0.1 * nrm(ks[6], (DA_HEAD,), f32)
    inp['l0_lam_q2'] = 0.1 * nrm(ks[7], (DA_HEAD,), f32)
    inp['l0_lam_k2'] = 0.1 * nrm(ks[8], (DA_HEAD,), f32)
    inp['l0_head_norm_g'] = 1.0 + 0.02 * nrm(ks[9], (DA_VDIM,), f32)
    inp['l0_w_out'] = nrm(ks[10], (E, D), f32) * E ** -0.5
    inp['l1_norm_g'] = 1.0 + 0.02 * nrm(ks[11], (D,), f32)
    inp['l1_w_in'] = nrm(ks[12], (D, 2 * E), f32) * D ** -0.5
    n = jnp.arange(P, dtype=f32)
    inp['l1_lam_re'] = -0.5 + 0.01 * nrm(ks[13], (G, P), f32)
    inp['l1_lam_im'] = jnp.pi * n[None, :] + 0.01 * nrm(ks[14], (G, P), f32)
    inp['l1_log_dt'] = jax.random.uniform(ks[15], (G,), f32, math.log(DT_MIN), math.log(DT_MAX))
    inp['l1_b_re'] = nrm(ks[16], (G, P, C), f32) * (2.0 * C) ** -0.5
    inp['l1_b_im'] = nrm(ks[17], (G, P, C), f32) * (2.0 * C) ** -0.5
    inp['l1_c_re'] = nrm(ks[18], (G, C, P), f32) * (2.0 * P) ** -0.5
    inp['l1_c_im'] = nrm(ks[19], (G, C, P), f32) * (2.0 * P) ** -0.5
    inp['l1_d'] = 1.0 + 0.1 * nrm(ks[20], (E,), f32)
    inp['l1_w_glu'] = nrm(ks[21], (E, E), f32) * E ** -0.5
    inp['l1_b_glu'] = 0.01 * nrm(ks[22], (E,), f32)
    inp['l1_w_out'] = nrm(ks[23], (E, D), f32) * E ** -0.5
    return inp


def reference(x, l0_norm_g, l0_w_in, l0_q_norm_g, l0_k_norm_g, l0_lam_q1, l0_lam_k1,
              l0_lam_q2, l0_lam_k2, l0_head_norm_g, l0_w_out,
              l1_norm_g, l1_w_in, l1_lam_re, l1_lam_im, l1_log_dt, l1_b_re, l1_b_im,
              l1_c_re, l1_c_im, l1_d, l1_w_glu, l1_b_glu, l1_w_out):
    mixers = [
        lambda h: diff_attention_layer(h, l0_norm_g, l0_w_in, l0_q_norm_g, l0_k_norm_g,
                                       l0_lam_q1, l0_lam_k1, l0_lam_q2, l0_lam_k2,
                                       l0_head_norm_g, l0_w_out, 0),
        lambda h: s5_layer(h, l1_norm_g, l1_w_in, l1_lam_re, l1_lam_im, l1_log_dt,
                           l1_b_re, l1_b_im, l1_c_re, l1_c_im, l1_d, l1_w_glu,
                           l1_b_glu, l1_w_out),
    ]
    for i in range(DEPTH):
        x = mixers[i % N_MIXERS](x)
    return x
```

```cpp
#include <hip/hip_runtime.h>
#include <hip/hip_cooperative_groups.h>
#include <cstdio>
#include <cstdint>
namespace cg = cooperative_groups;
namespace pg8 {
#define PG8_LAS __attribute__((address_space(3)))
typedef unsigned short bf16_t;
typedef short bf16x8 __attribute__((ext_vector_type(8)));
typedef float f32x4 __attribute__((ext_vector_type(4)));
typedef unsigned u32x4 __attribute__((ext_vector_type(4)));
constexpr int BM = 256, BK = 64, HALF = 128, HTB = HALF * BK * 2  , STAGE_BYTES = 8 * HTB, NXCD = 8, WGM = 4;

__host__ __device__ __forceinline__ int lds_byte(int r, int c) { const int st = (r >> 4) * 2 + (c >> 5), rr = r & 15, cc = c & 31, ob = rr * 64 + cc * 2; return st * 1024 + (ob ^ (((ob >> 9) & 1) << 5)); }
__host__ __device__ __forceinline__ void stage_rc(int b, int& R, int& C) { const int st = b / 1024, sb = b % 1024, swz = sb ^ (((sb >> 9) & 1) << 5); R = (st >> 1) * 16 + swz / 64; C = (st & 1) * 32 + (swz % 64) / 2; }
__host__ __device__ __forceinline__ int perm32(int rho) { const int n = rho >> 4, i = rho & 15; return 8 * (i >> 2) + 4 * n + (i & 3); }

struct Unit { int pm, pn; };
struct Gemm { const bf16_t* A; const bf16_t* Bt; int M, N, K; };

struct StaticOrder {
    int nM, nN, nwg, G, c;
    __host__ __device__ void init(int M, int N, int G_, int c_) { nM = M / BM; nN = N / BM; nwg = nM * nN; G = G_; c = c_; }
    __host__ __device__ bool next(int i, Unit& u) const {
        const long L = (long)i * G + c; if (L >= nwg) return false;
        int wgid = (int)L; { const int q = nwg / NXCD, r = nwg % NXCD, xcd = wgid % NXCD, off = wgid / NXCD; wgid = (xcd < r ? xcd * (q + 1) : r * (q + 1) + (xcd - r) * q) + off; }
        const int nig = WGM * nN, gid = wgid / nig, fm = gid * WGM, gsz = (nM - fm) < WGM ? (nM - fm) : WGM;
        u.pm = fm + ((wgid % nig) % gsz); u.pn = (wgid % nig) / gsz; return true;
    }
    __device__ __forceinline__ void a_ready(const Unit&) const {}
    __device__ __forceinline__ void done(const Unit&) const {}
};

__device__ __forceinline__ unsigned cvt_pk_bf16(float lo, float hi) { unsigned r; asm volatile("v_cvt_pk_bf16_f32 %0, %1, %2" : "=v"(r) : "v"(lo), "v"(hi)); return r; }
template <class Epi, class Sched, bool ALIGN_EPI = false, bool SP2 = false>
__device__ __forceinline__ void gemm_phase(PG8_LAS unsigned char* lds, const Gemm g, const Sched& S, const Epi& E, int tid_in) {
    int tid = tid_in; asm volatile("" : "+v"(tid));
    const int wid = __builtin_amdgcn_readfirstlane(tid >> 6), lane = tid & 63, wr = wid >> 2, wc = wid & 3, fr = lane & 15, fq = lane >> 4;
    const int K = g.K, nt = K / BK;
    unsigned voffA[2], voffB[2];
#pragma unroll
    for (int i = 0; i < 2; ++i) { int R, C; stage_rc(tid * 16 + i * 8192, R, C); const int Rb = Epi::PERM ? ((R & ~31) + perm32(R & 31)) : R;
        voffA[i] = (unsigned)(R * K + C) * 2u; voffB[i] = (unsigned)(Rb * K + C) * 2u; }
    const size_t kstep = (size_t)(BK * 2);
    const size_t hstep = (size_t)HALF * K * 2;
    const size_t tstep = 2 * hstep;
    const unsigned ldsw = (unsigned)wid * 1024u;
    const int aoff = lds_byte(wr * 64 + fr, fq * 8), boff = lds_byte(wc * 32 + fr, fq * 8);
#define PG8_SA(b, h) (((b) * 2 + (h)) * HTB)
#define PG8_SB(b, h) ((4 + (b) * 2 + (h)) * HTB)
#define PG8_STAGE(bufoff, gbase, voff) do { _Pragma("unroll") for (int _i = 0; _i < 2; ++_i) \
        __builtin_amdgcn_global_load_lds((const unsigned*)((const char*)(gbase) + (voff)[_i]), (PG8_LAS unsigned*)(lds + (bufoff) + ldsw + _i * 8192), 16, 0, 0); } while (0)
#define PG8_LDA(dst, b, h) do { _Pragma("unroll") for (int m = 0; m < 4; ++m) _Pragma("unroll") for (int k = 0; k < 2; ++k) dst[m][k] = *(const PG8_LAS bf16x8*)(lds + PG8_SA(b, h) + aoff + m * 2048 + k * 1024); } while (0)
#define PG8_LDB(dst, b, h) do { _Pragma("unroll") for (int n = 0; n < 2; ++n) _Pragma("unroll") for (int k = 0; k < 2; ++k) dst[n][k] = *(const PG8_LAS bf16x8*)(lds + PG8_SB(b, h) + boff + n * 2048 + k * 1024); } while (0)
#define PG8_MMA(ai, bj, At, Bt) do { __builtin_amdgcn_s_setprio(1); _Pragma("unroll") for (int m = 0; m < 4; ++m) _Pragma("unroll") for (int n = 0; n < 2; ++n) _Pragma("unroll") for (int k = 0; k < 2; ++k) \
        acc[ai][bj][m][n] = __builtin_amdgcn_mfma_f32_16x16x32_bf16(Bt[n][k], At[m][k], acc[ai][bj][m][n], 0, 0, 0); __builtin_amdgcn_s_setprio(0); } while (0)
#define PG8_WAIT_V(n) asm volatile("s_waitcnt vmcnt(" #n ")" ::: "memory")
#define PG8_WAIT_L(n) asm volatile("s_waitcnt lgkmcnt(" #n ")" ::: "memory")
#define PG8_BAR __builtin_amdgcn_s_barrier()
#define PG8_SCHED __builtin_amdgcn_sched_barrier(0)
    Unit cur, nxt; int ui = 0;
    if (!S.next(0, cur)) return;
    f32x4 acc[2][2][4][2];
#pragma unroll
    for (int a = 0; a < 2; ++a)
#pragma unroll
        for (int b = 0; b < 2; ++b)
#pragma unroll
            for (int m = 0; m < 4; ++m)
#pragma unroll
                for (int n = 0; n < 2; ++n) acc[a][b][m][n] = (f32x4){0.f, 0.f, 0.f, 0.f};
    bf16x8 At[4][2], B0[2][2], B1[2][2];
    const char* cA = (const char*)g.A + (size_t)cur.pm * tstep; const char* cB = (const char*)g.Bt + (size_t)cur.pn * tstep;
    S.a_ready(cur);
    if constexpr (SP2) {
        PG8_STAGE(PG8_SB(0, 0), cB, voffB); PG8_STAGE(PG8_SB(0, 1), cB + hstep, voffB); PG8_STAGE(PG8_SA(0, 0), cA, voffA); PG8_STAGE(PG8_SA(0, 1), cA + hstep, voffA);
        if (wr == 1) PG8_BAR;
        PG8_WAIT_V(2); PG8_BAR;
        PG8_STAGE(PG8_SB(1, 0), cB + kstep, voffB); PG8_STAGE(PG8_SA(1, 0), cA + kstep, voffA); PG8_STAGE(PG8_SB(1, 1), cB + hstep + kstep, voffB);
        PG8_WAIT_V(6); PG8_BAR;
    } else {
        PG8_STAGE(PG8_SB(0, 0), cB, voffB); PG8_STAGE(PG8_SA(0, 0), cA, voffA); PG8_STAGE(PG8_SB(0, 1), cB + hstep, voffB); PG8_STAGE(PG8_SA(0, 1), cA + hstep, voffA);
        if (wr == 1) PG8_BAR;
        PG8_WAIT_V(4); PG8_BAR;
        PG8_STAGE(PG8_SB(1, 0), cB + kstep, voffB); PG8_STAGE(PG8_SA(1, 0), cA + kstep, voffA); PG8_STAGE(PG8_SB(1, 1), cB + hstep + kstep, voffB);
        PG8_WAIT_V(6); PG8_BAR;
    }
    for (;;) {
        const bool has_next = S.next(ui + 1, nxt);
        const char* nA = has_next ? (const char*)g.A + (size_t)nxt.pm * tstep : cA; const char* nB = has_next ? (const char*)g.Bt + (size_t)nxt.pn * tstep : cB;
        for (int t = 0; t < nt; t += 2) {
            const bool last = (t == nt - 2);
            const char* a1 = cA + (size_t)(t + 1) * kstep;
            const char* a2 = last ? nA : cA + (size_t)(t + 2) * kstep; const char* b2 = last ? nB : cB + (size_t)(t + 2) * kstep;
            const char* a3 = a2 + kstep; const char* b3 = b2 + kstep;
            if (last && has_next) S.a_ready(nxt);
            if constexpr (SP2) {
            PG8_LDB(B0, 0, 0); PG8_LDB(B1, 0, 1); PG8_SCHED; PG8_LDA(At, 0, 0); PG8_STAGE(PG8_SA(1, 1), a1 + hstep, voffA);
            PG8_WAIT_V(8); PG8_WAIT_L(0); PG8_BAR; PG8_MMA(0, 0, At, B0); PG8_MMA(0, 1, At, B1); PG8_BAR; PG8_SCHED;
            PG8_LDA(At, 0, 1); PG8_STAGE(PG8_SB(0, 0), b2, voffB); PG8_STAGE(PG8_SB(0, 1), b2 + hstep, voffB); PG8_STAGE(PG8_SA(0, 0), a2, voffA);
            PG8_WAIT_V(8); PG8_WAIT_L(0); PG8_BAR; PG8_MMA(1, 0, At, B0); PG8_MMA(1, 1, At, B1); PG8_BAR; PG8_SCHED;
            PG8_LDB(B0, 1, 0); PG8_LDB(B1, 1, 1); PG8_SCHED; PG8_LDA(At, 1, 0); PG8_STAGE(PG8_SA(0, 1), a2 + hstep, voffA);
            PG8_WAIT_V(8); PG8_WAIT_L(0); PG8_BAR; PG8_MMA(0, 0, At, B0); PG8_MMA(0, 1, At, B1); PG8_BAR; PG8_SCHED;
            PG8_LDA(At, 1, 1); PG8_STAGE(PG8_SB(1, 0), b3, voffB); PG8_STAGE(PG8_SB(1, 1), b3 + hstep, voffB); PG8_STAGE(PG8_SA(1, 0), a3, voffA);
            PG8_WAIT_V(8); PG8_WAIT_L(0); PG8_BAR; PG8_MMA(1, 0, At, B0); PG8_MMA(1, 1, At, B1); PG8_BAR; PG8_SCHED;
            } else {
            PG8_LDB(B0, 0, 0); PG8_SCHED; PG8_LDA(At, 0, 0); PG8_STAGE(PG8_SA(1, 1), a1 + hstep, voffA);
            PG8_WAIT_L(8); PG8_BAR; PG8_WAIT_L(0); PG8_MMA(0, 0, At, B0); PG8_BAR; PG8_SCHED;
            PG8_LDB(B1, 0, 1); PG8_STAGE(PG8_SB(0, 0), b2, voffB);
            PG8_BAR; PG8_WAIT_L(0); PG8_MMA(0, 1, At, B1); PG8_BAR;
            PG8_LDA(At, 0, 1); PG8_STAGE(PG8_SA(0, 0), a2, voffA);
            PG8_BAR; PG8_WAIT_L(0); PG8_MMA(1, 0, At, B0); PG8_BAR; PG8_SCHED;
            PG8_STAGE(PG8_SB(0, 1), b2 + hstep, voffB);
            PG8_WAIT_V(6); PG8_BAR; PG8_MMA(1, 1, At, B1); PG8_BAR;
            PG8_LDB(B0, 1, 0); PG8_SCHED; PG8_LDA(At, 1, 0); PG8_STAGE(PG8_SA(0, 1), a2 + hstep, voffA);
            PG8_WAIT_L(8); PG8_BAR; PG8_WAIT_L(0); PG8_MMA(0, 0, At, B0); PG8_BAR; PG8_SCHED;
            PG8_LDB(B1, 1, 1); PG8_STAGE(PG8_SB(1, 0), b3, voffB);
            PG8_BAR; PG8_WAIT_L(0); PG8_MMA(0, 1, At, B1); PG8_BAR;
            PG8_LDA(At, 1, 1); PG8_STAGE(PG8_SA(1, 0), a3, voffA);
            PG8_BAR; PG8_WAIT_L(0); PG8_MMA(1, 0, At, B0); PG8_BAR; PG8_SCHED;
            PG8_STAGE(PG8_SB(1, 1), b3 + hstep, voffB);
            PG8_WAIT_V(6); PG8_BAR; PG8_MMA(1, 1, At, B1); PG8_BAR;
            }
        }
        if constexpr (ALIGN_EPI) { if (wr == 0) PG8_BAR; }
        if constexpr (!Epi::AFTER_DRAIN) { E(acc, cur, wr, wc, fr, fq); S.done(cur); }
        if (!has_next) break;
#pragma unroll
        for (int a = 0; a < 2; ++a)
#pragma unroll
            for (int b = 0; b < 2; ++b)
#pragma unroll
                for (int m = 0; m < 4; ++m)
#pragma unroll
                    for (int n = 0; n < 2; ++n) acc[a][b][m][n] = (f32x4){0.f, 0.f, 0.f, 0.f};
        cur = nxt; cA = nA; cB = nB; ++ui;
        if constexpr (ALIGN_EPI) { if (wr == 1) PG8_BAR; }
    }
    PG8_WAIT_V(0);
    if constexpr (!ALIGN_EPI) { if (wr == 0) PG8_BAR; }
    PG8_BAR;
    if constexpr (Epi::AFTER_DRAIN) { E.fused(acc, cur, wr, wc, fr, fq, lds, wid, lane); S.done(cur); }
#undef PG8_SA
#undef PG8_SB
#undef PG8_STAGE
#undef PG8_LDA
#undef PG8_LDB
#undef PG8_MMA
#undef PG8_WAIT_V
#undef PG8_WAIT_L
#undef PG8_BAR
#undef PG8_SCHED
}
}
using pg8::bf16_t; using pg8::f32x4; using pg8::u32x4; using pg8::Unit;
#define LAS __attribute__((address_space(3)))
constexpr int NB = 8, SEQ = 4096, DM = 1024, BR = 2048, MT = NB * SEQ, NH = 16;
constexpr float EPS = 1e-6f, LOG2E = 1.4426950408889634f, C2 = 0.125f * LOG2E, LAM0 = 0.2f;
constexpr size_t MiB = 1u << 20;
constexpr size_t WS_W0 = 0, WS_WO0 = 16 * MiB, WS_W1 = 20 * MiB, WS_WG = 28 * MiB, WS_WO1 = 36 * MiB, WS_XN = 40 * MiB;
constexpr size_t WS_Q = 104 * MiB, WS_K = 232 * MiB, WS_V = 360 * MiB, WS_MISC = 488 * MiB, WS_END = 512 * MiB;
constexpr size_t MISC_ROWSS = 0;
constexpr int LDS_BYTES = 147456;
constexpr int NTHREADS = 512, NWAVES = 8;

__device__ __forceinline__ unsigned f2bf(float f) { unsigned u = __builtin_bit_cast(unsigned, f); return (u + 0x7fffu + ((u >> 16) & 1u)) >> 16; }
__device__ __forceinline__ unsigned pk2(float lo, float hi) { return pg8::cvt_pk_bf16(lo, hi); }
__device__ __forceinline__ float bflo(unsigned u) { return __builtin_bit_cast(float, u << 16); }
__device__ __forceinline__ float bfhi(unsigned u) { return __builtin_bit_cast(float, u & 0xffff0000u); }
__device__ __forceinline__ float bf1(bf16_t h) { return __builtin_bit_cast(float, (unsigned)h << 16); }
__device__ __forceinline__ float wave_sum(float v) {
#pragma unroll
    for (int o = 1; o < 64; o <<= 1) v += __shfl_xor(v, o);
    return v;
}
__device__ __forceinline__ float wave_max(float v) {
#pragma unroll
    for (int o = 1; o < 64; o <<= 1) v = fmaxf(v, __shfl_xor(v, o));
    return v;
}
__device__ __forceinline__ float sigmoidf_(float v) { return __builtin_amdgcn_rcpf(1.f + __builtin_amdgcn_exp2f(-LOG2E * v)); }
__device__ __forceinline__ float siluf_(float v) { return v * __builtin_amdgcn_rcpf(1.f + __builtin_amdgcn_exp2f(-LOG2E * v)); }
__device__ __forceinline__ float gelu_tanh(float y) { const float t = (-1.5957691216057308f * LOG2E) * (y + 0.044715f * y * y * y); return y * __builtin_amdgcn_rcpf(1.f + __builtin_amdgcn_exp2f(t)); }
__device__ __forceinline__ u32x4 pack8(const f32x4& a, const f32x4& b) { u32x4 w; w.x = pk2(a[0], a[1]); w.y = pk2(a[2], a[3]); w.z = pk2(b[0], b[1]); w.w = pk2(b[2], b[3]); return w; }

struct Params {
    const float* in[24]; float* out; unsigned char* ws;
};

typedef f32x4 AccT[2][2][4][2];
struct EpiQKZ {
    static constexpr bool PERM = true, AFTER_DRAIN = false;
    bf16_t *Q, *K, *Z; const float *gq, *gk; int pn_off;
    __device__ __forceinline__ void operator()(const AccT& acc, const Unit& u, int wr, int wc, int fr, int fq) const {
        const int kind = (u.pn + pn_off) >> 3, tile = (u.pn + pn_off) & 7;
        bf16_t* base = Q + (size_t)kind * ((WS_K - WS_Q) / 2); if (kind == 2) base = Z;
        const float* g = gq; if (kind == 1) g = gk; const float gs = kind == 0 ? C2 : 1.f;
        f32x4 gv[2][2];
#pragma unroll
        for (int bj = 0; bj < 2; ++bj)
#pragma unroll
            for (int n = 0; n < 2; ++n) gv[bj][n] = (kind < 2) ? *(const f32x4*)(g + 32 * bj + 8 * fq + 4 * n) * gs : (f32x4){1.f, 1.f, 1.f, 1.f};
        const int row0 = u.pm * 256 + wr * 64 + fr;
#pragma unroll
        for (int ai = 0; ai < 2; ++ai)
#pragma unroll
            for (int m = 0; m < 4; ++m) {
                const int row = row0 + ai * 128 + m * 16; float rs = 1.f;
                if (kind < 2) { float ss = 0.f;
#pragma unroll
                    for (int bj = 0; bj < 2; ++bj)
#pragma unroll
                        for (int n = 0; n < 2; ++n) { const f32x4 v = acc[ai][bj][m][n]; ss += (v[0] * v[0] + v[1] * v[1]) + (v[2] * v[2] + v[3] * v[3]); }
                    ss += __shfl_xor(ss, 16); ss += __shfl_xor(ss, 32); rs = rsqrtf(ss * (1.f / 64.f) + EPS); }
                bf16_t* rp = base + (size_t)row * BR + tile * 256 + 64 * wc + 8 * fq;
#pragma unroll
                for (int bj = 0; bj < 2; ++bj) { const f32x4 v0 = acc[ai][bj][m][0] * rs * gv[bj][0], v1 = acc[ai][bj][m][1] * rs * gv[bj][1];
                    __builtin_nontemporal_store(pack8(v0, v1), (u32x4*)(rp + 32 * bj)); }
            }
    }
};
struct EpiVt {
    static constexpr bool PERM = true, AFTER_DRAIN = false;
    bf16_t* Vt;
    __device__ __forceinline__ void operator()(const AccT& acc, const Unit& u, int wr, int wc, int fr, int fq) const {
        const int b = u.pn >> 4, s0 = (u.pn & 15) * 256 + wc * 32 + 8 * fq, vrow0 = u.pm * 256 + wr * 64 + fr;
#pragma unroll
        for (int ai = 0; ai < 2; ++ai)
#pragma unroll
            for (int m = 0; m < 4; ++m) { bf16_t* rp = Vt + ((size_t)(b * BR + vrow0 + ai * 128 + m * 16)) * SEQ + s0;
#pragma unroll
                for (int bj = 0; bj < 2; ++bj) __builtin_nontemporal_store(pack8(acc[ai][bj][m][0], acc[ai][bj][m][1]), (u32x4*)(rp + bj * 128)); }
    }
};
struct EpiWo0 {
    static constexpr bool PERM = true, AFTER_DRAIN = false;
    const float* x; float* x1; bf16_t* xb; float* rowss;
    __device__ __forceinline__ void operator()(const AccT& acc, const Unit& u, int wr, int wc, int fr, int fq) const {
        const int row0 = u.pm * 256 + wr * 64 + fr, col0 = u.pn * 256 + wc * 32 + 8 * fq;
#pragma unroll
        for (int ai = 0; ai < 2; ++ai)
#pragma unroll
            for (int m = 0; m < 4; ++m) { const int row = row0 + ai * 128 + m * 16; float ss = 0.f;
#pragma unroll
                for (int bj = 0; bj < 2; ++bj) { const size_t o = (size_t)row * DM + col0 + bj * 128;
                    const f32x4 v0 = acc[ai][bj][m][0] + *(const f32x4*)(x + o), v1 = acc[ai][bj][m][1] + *(const f32x4*)(x + o + 4);
                    *(u32x4*)(xb + o) = pack8(v0, v1);
                    ss += (v0[0] * v0[0] + v0[1] * v0[1]) + (v0[2] * v0[2] + v0[3] * v0[3]) + (v1[0] * v1[0] + v1[1] * v1[1]) + (v1[2] * v1[2] + v1[3] * v1[3]); }
                ss += __shfl_xor(ss, 16); ss += __shfl_xor(ss, 32);
                if (fq == 0) atomicAdd(rowss + row, ss); }
    }
};
struct EpiUZ {
    static constexpr bool PERM = true, AFTER_DRAIN = false;
    bf16_t *U, *Zs; const float* rowss;
    __device__ __forceinline__ void operator()(const AccT& acc, const Unit& u, int wr, int wc, int fr, int fq) const {
        const int kind = u.pn >> 3, tile = u.pn & 7; bf16_t* base = kind ? Zs : U;
        const int row0 = u.pm * 256 + wr * 64 + fr, col0 = tile * 256 + wc * 32 + 8 * fq;
#pragma unroll
        for (int ai = 0; ai < 2; ++ai)
#pragma unroll
            for (int m = 0; m < 4; ++m) { const int row = row0 + ai * 128 + m * 16; const float rs = rsqrtf(rowss[row] * (1.f / DM) + EPS);
#pragma unroll
                for (int bj = 0; bj < 2; ++bj) { f32x4 v0 = acc[ai][bj][m][0] * rs, v1 = acc[ai][bj][m][1] * rs;
                    if (kind) {
#pragma unroll
                        for (int j = 0; j < 4; ++j) { v0[j] = siluf_(v0[j]); v1[j] = siluf_(v1[j]); } }
                    __builtin_nontemporal_store(pack8(v0, v1), (u32x4*)(base + (size_t)row * BR + col0 + bj * 128)); } }
    }
};
struct EpiGLU {
    static constexpr bool PERM = true, AFTER_DRAIN = false;
    const bf16_t *YG, *Zs; bf16_t* YZ; const float* bias;
    __device__ __forceinline__ void operator()(const AccT& acc, const Unit& u, int wr, int wc, int fr, int fq) const {
        const int row0 = u.pm * 256 + wr * 64 + fr, col0 = u.pn * 256 + wc * 32 + 8 * fq;
#pragma unroll
        for (int bj = 0; bj < 2; ++bj) { const int c = col0 + bj * 128; const f32x4 b0 = *(const f32x4*)(bias + c), b1 = *(const f32x4*)(bias + c + 4);
#pragma unroll
            for (int ai = 0; ai < 2; ++ai)
#pragma unroll
                for (int m = 0; m < 4; ++m) { const size_t o = (size_t)(row0 + ai * 128 + m * 16) * BR + c;
                    const u32x4 y8 = *(const u32x4*)(YG + o), z8 = *(const u32x4*)(Zs + o);
                    const f32x4 g0 = acc[ai][bj][m][0] + b0, g1 = acc[ai][bj][m][1] + b1; f32x4 v0, v1;
                    v0[0] = bflo(y8.x) * bflo(z8.x) * sigmoidf_(g0[0]); v0[1] = bfhi(y8.x) * bfhi(z8.x) * sigmoidf_(g0[1]);
                    v0[2] = bflo(y8.y) * bflo(z8.y) * sigmoidf_(g0[2]); v0[3] = bfhi(y8.y) * bfhi(z8.y) * sigmoidf_(g0[3]);
                    v1[0] = bflo(y8.z) * bflo(z8.z) * sigmoidf_(g1[0]); v1[1] = bfhi(y8.z) * bfhi(z8.z) * sigmoidf_(g1[1]);
                    v1[2] = bflo(y8.w) * bflo(z8.w) * sigmoidf_(g1[2]); v1[3] = bfhi(y8.w) * bfhi(z8.w) * sigmoidf_(g1[3]);
                    __builtin_nontemporal_store(pack8(v0, v1), (u32x4*)(YZ + o)); } }
    }
};
struct EpiOut {
    static constexpr bool PERM = true, AFTER_DRAIN = false;
    float* out; const bf16_t* xb;
    __device__ __forceinline__ void operator()(const AccT& acc, const Unit& u, int wr, int wc, int fr, int fq) const {
        const int row0 = u.pm * 256 + wr * 64 + fr, col0 = u.pn * 256 + wc * 32 + 8 * fq;
#pragma unroll
        for (int ai = 0; ai < 2; ++ai)
#pragma unroll
            for (int m = 0; m < 4; ++m)
#pragma unroll
                for (int bj = 0; bj < 2; ++bj) { const size_t o = (size_t)(row0 + ai * 128 + m * 16) * DM + col0 + bj * 128; float* p = out + o;
                    const u32x4 x8 = *(const u32x4*)(xb + o);
                    const f32x4 v0 = acc[ai][bj][m][0] + (f32x4){bflo(x8.x), bfhi(x8.x), bflo(x8.y), bfhi(x8.y)}, v1 = acc[ai][bj][m][1] + (f32x4){bflo(x8.z), bfhi(x8.z), bflo(x8.w), bfhi(x8.w)};
                    __builtin_nontemporal_store(v0, (f32x4*)p); __builtin_nontemporal_store(v1, (f32x4*)(p + 4)); }
    }
};
__device__ __forceinline__ void tr_item(const float* W, int N, int K, bf16_t* WT, int n0, int k0, int drow0, const float* kscale, LAS float* scr, int lane) {
    float tv[32];
#pragma unroll
    for (int i = 0; i < 32; ++i) tv[i] = __builtin_nontemporal_load(W + (size_t)(k0 + 2 * i + (lane >> 5)) * N + n0 + (lane & 31));
#pragma unroll
    for (int i = 0; i < 32; ++i) { const int kk = 2 * i + (lane >> 5); float v = tv[i]; if (kscale) v *= kscale[k0 + kk]; scr[kk * 33 + (lane & 31)] = v; }
    asm volatile("s_waitcnt lgkmcnt(0)" ::: "memory");
    const int c = lane & 7;
#pragma unroll
    for (int j = 0; j < 4; ++j) { const int n = (lane >> 3) + 8 * j; const LAS float* s = scr + (8 * c) * 33 + n;
        u32x4 o; o.x = pk2(s[0 * 33], s[1 * 33]); o.y = pk2(s[2 * 33], s[3 * 33]); o.z = pk2(s[4 * 33], s[5 * 33]); o.w = pk2(s[6 * 33], s[7 * 33]);
        *(u32x4*)(WT + (size_t)(drow0 + n) * K + k0 + 8 * c) = o; }
    asm volatile("s_waitcnt lgkmcnt(0)" ::: "memory");
}
__device__ __forceinline__ int map_w0(int n0) {
    const int sec = n0 >> 11, r = n0 & 2047;
    if (sec == 2) return 6144 + r;
    const int tile = r >> 8, L = r & 255, wcg = L >> 6, bjg = (L & 63) >> 5, p = 128 * bjg + 32 * wcg;
    const int base = sec == 0 ? 0 : (sec == 1 ? 2048 : 4096);
    return base + 256 * tile + p;
}
__device__ __forceinline__ void prologue(const Params& P, LAS unsigned char* lds, int gw, int NGW, int wave, int lane) {
    unsigned char* ws = P.ws;
    LAS float* scr = (LAS float*)(lds + wave * 16384);
    constexpr int I0 = (DM / 64) * (4 * BR / 32), IO = (BR / 64) * (DM / 32), I1 = (DM / 64) * (2 * BR / 32), IG = (BR / 64) * (BR / 32);
    constexpr int NIT = I0 + IO + I1 + IG + IO;
    for (int it = gw; it < NIT; it += NGW) {
        int r = it;
        if (r < I0) { const int nblk = 4 * BR / 32, kb = r / nblk, nb = r % nblk; tr_item(P.in[2], 4 * BR, DM, (bf16_t*)(ws + WS_W0), 32 * nb, 64 * kb, map_w0(32 * nb), nullptr, scr, lane); continue; } r -= I0;
        if (r < IO) { const int nblk = DM / 32, kb = r / nblk, nb = r % nblk; tr_item(P.in[10], DM, BR, (bf16_t*)(ws + WS_WO0), 32 * nb, 64 * kb, 32 * nb, nullptr, scr, lane); continue; } r -= IO;
        if (r < I1) { const int nblk = 2 * BR / 32, kb = r / nblk, nb = r % nblk; tr_item(P.in[12], 2 * BR, DM, (bf16_t*)(ws + WS_W1), 32 * nb, 64 * kb, 32 * nb, P.in[11], scr, lane); continue; } r -= I1;
        if (r < IG) { const int nblk = BR / 32, kb = r / nblk, nb = r % nblk; tr_item(P.in[21], BR, BR, (bf16_t*)(ws + WS_WG), 32 * nb, 64 * kb, 32 * nb, nullptr, scr, lane); continue; } r -= IG;
        { const int nblk = DM / 32, kb = r / nblk, nb = r % nblk; tr_item(P.in[23], DM, BR, (bf16_t*)(ws + WS_WO1), 32 * nb, 64 * kb, 32 * nb, nullptr, scr, lane); }
    }
    const float* x = P.in[0]; const float* g0 = P.in[1]; bf16_t* XN = (bf16_t*)(ws + WS_XN);
    f32x4 gv[4];
#pragma unroll
    for (int j = 0; j < 4; ++j) gv[j] = *((const f32x4*)g0 + lane + 64 * j);
    for (int m0 = gw * 4; m0 < MT; m0 += NGW * 4) {
        f32x4 v[4][4]; float s2[4];
#pragma unroll
        for (int q = 0; q < 4; ++q) { const f32x4* xr = (const f32x4*)(x + (size_t)(m0 + q) * DM) + lane;
#pragma unroll
            for (int j = 0; j < 4; ++j) v[q][j] = __builtin_nontemporal_load(xr + 64 * j); }
#pragma unroll
        for (int q = 0; q < 4; ++q) { float a = 0.f;
#pragma unroll
            for (int j = 0; j < 4; ++j) a += (v[q][j][0] * v[q][j][0] + v[q][j][1] * v[q][j][1]) + (v[q][j][2] * v[q][j][2] + v[q][j][3] * v[q][j][3]);
            s2[q] = a; }
#pragma unroll
        for (int o = 1; o < 64; o <<= 1) {
#pragma unroll
            for (int q = 0; q < 4; ++q) s2[q] += __shfl_xor(s2[q], o); }
#pragma unroll
        for (int q = 0; q < 4; ++q) { const float rs = rsqrtf(s2[q] * (1.f / DM) + EPS);
            unsigned long long* o8 = (unsigned long long*)(XN + (size_t)(m0 + q) * DM) + lane;
#pragma unroll
            for (int j = 0; j < 4; ++j) { const f32x4 w = v[q][j] * rs * gv[j]; o8[64 * j] = (unsigned long long)pk2(w[0], w[1]) | ((unsigned long long)pk2(w[2], w[3]) << 32); } }
    }
    float* rowss = (float*)(ws + WS_MISC + MISC_ROWSS);
    for (int i = gw * 64 + lane; i < MT; i += NGW * 64) rowss[i] = 0.f;
    if (gw == 0 && lane < 8) ((unsigned*)(ws + WS_MISC + 128 * 1024))[64 * lane] = 0u;
    if (gw == 2 && lane < 9) ((unsigned*)(ws + WS_MISC + 160 * 1024))[64 * lane] = 0u;
    if (gw == 1) {
        float* tab = (float*)(ws + WS_MISC + 192 * 1024);
        const float lam = __expf(wave_sum(P.in[5][lane] * P.in[6][lane])) - __expf(wave_sum(P.in[7][lane] * P.in[8][lane])) + LAM0;
        const float SB = 8.f * wave_max(fabsf(P.in[3][lane])) * wave_max(fabsf(P.in[4][lane])) * LOG2E * 1.01f;
        if (lane < 16) { const float s2 = exp2f(-0.5f * (float)(lane + 1)) * LOG2E; tab[lane] = s2; tab[16 + lane] = (2.f * SB + 25.f - log2f(1.f - exp2f(-s2))) / s2; }
        if (lane == 0) { tab[32] = lam; tab[33] = SB; }
    }
}

typedef short bf16x8 __attribute__((ext_vector_type(8)));
typedef short s16x4 __attribute__((ext_vector_type(4)));
typedef float f32x16 __attribute__((ext_vector_type(16)));
typedef unsigned u32x2 __attribute__((ext_vector_type(2)));
constexpr int KROW = 272, VROW = 136, KT_BYTES = 64 * KROW, VT_BYTES = 128 * VROW, AT_VOFF = 2 * KT_BYTES;
constexpr float ATT_THR = 8.f;
typedef float f32x2_t __attribute__((ext_vector_type(2))); typedef __bf16 bf16x2_t __attribute__((ext_vector_type(2)));
__device__ __forceinline__ unsigned cvtpk_s(float lo, float hi) { f32x2_t v = {lo, hi}; bf16x2_t b = __builtin_convertvector(v, bf16x2_t); return __builtin_bit_cast(unsigned, b); }
__device__ __forceinline__ float max3f(float a, float b, float c) { float r; asm("v_max3_f32 %0, %1, %2, %3" : "=v"(r) : "v"(a), "v"(b), "v"(c)); return r; }
__device__ __forceinline__ int crow(int r, int hi) { return (r & 3) + 8 * (r >> 2) + 4 * hi; }

template <int HF>
__device__ __forceinline__ void att_half(f32x16 (&o)[2][4], float (&lsum)[2], const bf16x8 (&qf)[2][4], const LAS unsigned char* kb, const LAS unsigned char* vb,
                                         float slope2, float SB, int kvh0  , int qw0, int r32, int hi, bool band,
                                         bool stage, u32x4 st0, u32x4 st1, LAS unsigned char* sdst  ) {
    u32x4 pw[2][2];
    float s2v = slope2; asm volatile("" : "+v"(s2v));
    const float tb = slope2 * (float)(kvh0 + 4 * hi - qw0 - r32) - SB;
#pragma unroll
    for (int sub = 0; sub < 2; ++sub) {
        f32x16 p;
#pragma unroll
        for (int r = 0; r < 16; ++r) p[r] = __builtin_fmaf(s2v, (float)((r & 3) + 8 * (r >> 2)), tb);
#pragma unroll
        for (int d0 = 0; d0 < 4; ++d0) { const bf16x8 kf = *(const LAS bf16x8*)(kb + HF * 32 * KROW + sub * 128 + d0 * 32);
            p = __builtin_amdgcn_mfma_f32_32x32x16_bf16(kf, qf[sub][d0], p, 0, 0, 0); }
        if (band) { const int lim = qw0 + r32 - (kvh0 + 4 * hi);
            asm volatile("s_nop 15" : "+v"(p));
            const float ninf = -INFINITY;
#pragma unroll
            for (int r = 0; r < 16; ++r) asm("v_cmp_gt_i32_e32 vcc, %2, %1\n\tv_cndmask_b32_e32 %0, %0, %3, vcc" : "+v"(p[r]) : "v"(lim), "i"((r & 3) + 8 * (r >> 2)), "v"(ninf) : "vcc"); }
        float ls = 0.f;
#pragma unroll
        for (int r = 0; r < 16; ++r) { p[r] = __builtin_amdgcn_exp2f(p[r]); ls += p[r]; }
        lsum[sub] += ls;
        pw[sub][0] = (u32x4){cvtpk_s(p[0], p[1]), cvtpk_s(p[2], p[3]), cvtpk_s(p[4], p[5]), cvtpk_s(p[6], p[7])};
        pw[sub][1] = (u32x4){cvtpk_s(p[8], p[9]), cvtpk_s(p[10], p[11]), cvtpk_s(p[12], p[13]), cvtpk_s(p[14], p[15])};
        __builtin_amdgcn_sched_barrier(0);
        if (sub == 0 && stage) {
            if (HF == 0) { *(LAS u32x4*)sdst = st0; *(LAS u32x4*)(sdst + 32 * KROW) = st1; }
            else { *(LAS u32x2*)sdst = (u32x2){st0.x, st0.y}; *(LAS u32x2*)(sdst + 8) = (u32x2){st0.z, st0.w}; *(LAS u32x2*)(sdst + 64 * VROW) = (u32x2){st1.x, st1.y}; *(LAS u32x2*)(sdst + 64 * VROW + 8) = (u32x2){st1.z, st1.w}; }
            __builtin_amdgcn_sched_barrier(0);
        }
    }
#define AT_VFRAG(idx) ({ const LAS unsigned char* va_ = vb + ((idx) & 3) * 32 * VROW + (2 * HF + ((idx) >> 2)) * 32; \
        const s16x4 lo_ = *(const LAS s16x4*)va_, hh_ = *(const LAS s16x4*)(va_ + 16); (bf16x8){lo_[0], lo_[1], lo_[2], lo_[3], hh_[0], hh_[1], hh_[2], hh_[3]}; })
    bf16x8 vcur = AT_VFRAG(0);
    __builtin_amdgcn_s_setprio(1);
#pragma unroll
    for (int idx = 0; idx < 8; ++idx) {
        bf16x8 vnext = vcur;
        if (idx + 1 < 8) vnext = AT_VFRAG(idx + 1);
        const int kk = idx >> 2, d = idx & 3;
        o[0][d] = __builtin_amdgcn_mfma_f32_32x32x16_bf16(vcur, __builtin_bit_cast(bf16x8, pw[0][kk]), o[0][d], 0, 0, 0);
        o[1][d] = __builtin_amdgcn_mfma_f32_32x32x16_bf16(vcur, __builtin_bit_cast(bf16x8, pw[1][kk]), o[1][d], 0, 0, 0);
        __builtin_amdgcn_sched_barrier(0);
        vcur = vnext;
    }
    __builtin_amdgcn_s_setprio(0);
#undef AT_VFRAG
}

__device__ __forceinline__ void attn_unit(int b, int h, int qb, bf16_t* Q, const bf16_t* __restrict__ K, const bf16_t* __restrict__ Vt, const bf16_t* __restrict__ Z, const float* __restrict__ hg, float lam,
                                          LAS unsigned char* lds, int tid, int wave, int lane, int tfirst, float SB, const float* __restrict__ tab, float Dwin) {
    const int r32 = lane & 31, hi = lane >> 5;
    const int q0u = qb * 256, qw0 = q0u + 32 * wave;
    const size_t rowbase = (size_t)b * SEQ;
    const float slope2 = __builtin_bit_cast(float, __builtin_amdgcn_readfirstlane(__builtin_bit_cast(int, tab[h])));
    bf16x8 qf[2][4];
    { const bf16_t* qp = Q + (rowbase + qw0 + r32) * BR + h * 128 + 8 * hi;
#pragma unroll
      for (int sub = 0; sub < 2; ++sub)
#pragma unroll
          for (int d0 = 0; d0 < 4; ++d0) qf[sub][d0] = *(const bf16x8*)(qp + sub * 64 + d0 * 16); }
    const unsigned kgo = (unsigned)(((rowbase + (tid >> 4)) * BR + h * 128 + (tid & 15) * 8) * 2);
    const int kl = (tid >> 4) * KROW + (tid & 15) * 16;
    const unsigned vgo = (unsigned)((((size_t)b * BR + h * 128 + (tid >> 3)) * SEQ + (tid & 7) * 8) * 2);
    const int vl = AT_VOFF + (tid >> 3) * VROW + (tid & 7) * 16;
    const int NT = 4 * (qb + 1), last_w = (qw0 + 31) >> 6;
    int tlo_w = 0; if (Dwin < 4096.f) { const int kmin_w = qw0 - (int)Dwin - 1; tlo_w = kmin_w > 0 ? (kmin_w >> 6) : 0; }
    f32x16 o[2][4];
#pragma unroll
    for (int s = 0; s < 2; ++s)
#pragma unroll
        for (int d = 0; d < 4; ++d)
#pragma unroll
            for (int r = 0; r < 16; ++r) o[s][d][r] = 0.f;
    float lsum[2] = {0.f, 0.f};
    u32x4 ks0, ks1, vs0, vs1;
#define AT_LOADK(tt) do { const unsigned ko = kgo + (unsigned)(tt) * (64 * BR * 2); ks0 = *(const u32x4*)((const char*)K + ko); ks1 = *(const u32x4*)((const char*)K + ko + 32 * BR * 2); } while (0)
#define AT_LOADV(tt) do { const unsigned vo = vgo + (unsigned)(tt) * 128; vs0 = *(const u32x4*)((const char*)Vt + vo); vs1 = *(const u32x4*)((const char*)Vt + vo + 64 * SEQ * 2); } while (0)
#define AT_WRITEK(buf) do { *(LAS u32x4*)(lds + (buf) * KT_BYTES + kl) = ks0; *(LAS u32x4*)(lds + (buf) * KT_BYTES + kl + 32 * KROW) = ks1; } while (0)
#define AT_WRITEV(buf) do { \
        *(LAS u32x2*)(lds + (buf) * VT_BYTES + vl) = (u32x2){vs0.x, vs0.y}; *(LAS u32x2*)(lds + (buf) * VT_BYTES + vl + 8) = (u32x2){vs0.z, vs0.w}; \
        *(LAS u32x2*)(lds + (buf) * VT_BYTES + vl + 64 * VROW) = (u32x2){vs1.x, vs1.y}; *(LAS u32x2*)(lds + (buf) * VT_BYTES + vl + 64 * VROW + 8) = (u32x2){vs1.z, vs1.w}; } while (0)
    AT_LOADK(tfirst); AT_LOADV(tfirst); AT_WRITEK(tfirst & 1); AT_WRITEV(tfirst & 1);
    __syncthreads();
    for (int t = tfirst; t < NT; ++t) {
        const int cur = t & 1; const bool more = (t + 1 < NT), active = (t <= last_w) && (t >= tlo_w), band = (64 * t + 63 > qw0);
        const LAS unsigned char* kb = lds + cur * KT_BYTES + r32 * KROW + hi * 16;
        const LAS unsigned char* vb = lds + AT_VOFF + cur * VT_BYTES + r32 * VROW + hi * 8;
        if (more) AT_LOADK(t + 1);
        __builtin_amdgcn_sched_barrier(0);
        if (active) att_half<0>(o, lsum, qf, kb, vb, slope2, SB, 64 * t, qw0, r32, hi, band, more, ks0, ks1, lds + (cur ^ 1) * KT_BYTES + kl);
        else if (more) AT_WRITEK(cur ^ 1);
        __builtin_amdgcn_sched_barrier(0);
        if (more) AT_LOADV(t + 1);
        __builtin_amdgcn_sched_barrier(0);
        if (active && (64 * t + 32 <= qw0 + 31)) att_half<1>(o, lsum, qf, kb, vb, slope2, SB, 64 * t + 32, qw0, r32, hi, band, more, vs0, vs1, lds + (cur ^ 1) * VT_BYTES + vl);
        else if (more) AT_WRITEV(cur ^ 1);
        __syncthreads();
    }
#undef AT_LOADK
#undef AT_LOADV
#undef AT_WRITEK
#undef AT_WRITEV
    const float l1 = lsum[0] + __shfl_xor(lsum[0], 32), l2 = lsum[1] + __shfl_xor(lsum[1], 32);
    const float i1 = 1.f / l1, i2 = lam / l2;
    float ss = 0.f;
#pragma unroll
    for (int d = 0; d < 4; ++d)
#pragma unroll
        for (int r = 0; r < 16; ++r) { const float v = o[0][d][r] * i1 - o[1][d][r] * i2; o[0][d][r] = v; ss += v * v; }
    ss += __shfl_xor(ss, 32);
    const float rs = rsqrtf(ss * (1.f / 128.f) + EPS) * (1.f - LAM0);
    int lane_l = lane; asm volatile("" : "+v"(lane_l));
    const size_t off = (rowbase + qw0 + (lane_l & 31)) * BR + h * 128 + 4 * (lane_l >> 5);
    __builtin_amdgcn_sched_barrier(0);
#pragma unroll
    for (int d = 0; d < 4; ++d)
#pragma unroll
        for (int i = 0; i < 4; ++i) { const int e = 32 * d + 8 * i; if ((i & 1) == 0) __builtin_amdgcn_sched_barrier(0);
            const f32x4 g4 = *(const f32x4*)(hg + e + 4 * (lane_l >> 5)); const u32x2 z2 = *(const u32x2*)(Z + off + e);
            const float v0 = o[0][d][4 * i] * rs * g4[0] * siluf_(bflo(z2.x)), v1 = o[0][d][4 * i + 1] * rs * g4[1] * siluf_(bfhi(z2.x));
            const float v2 = o[0][d][4 * i + 2] * rs * g4[2] * siluf_(bflo(z2.y)), v3 = o[0][d][4 * i + 3] * rs * g4[3] * siluf_(bfhi(z2.y));
            *(u32x2*)(Q + off + e) = (u32x2){pk2(v0, v1), pk2(v2, v3)}; }
}
constexpr size_t MISC_ATQ = 128 * 1024, MISC_ATT = 192 * 1024;
__device__ __forceinline__ void attn_phase(const Params& P, LAS unsigned char* lds, int bx, int tid_in) {
    int tid = tid_in; asm volatile("" : "+v"(tid)); const int lane = tid & 63, wave = __builtin_amdgcn_readfirstlane(tid >> 6);
    unsigned char* ws = P.ws;
    bf16_t* Q = (bf16_t*)(ws + WS_Q); const bf16_t* K = (const bf16_t*)(ws + WS_K); const bf16_t* Vt = (const bf16_t*)(ws + WS_V); const bf16_t* Z = (const bf16_t*)P.out;
    const float* tab = (const float*)(ws + WS_MISC + MISC_ATT);
    const float lam = __builtin_bit_cast(float, __builtin_amdgcn_readfirstlane(__builtin_bit_cast(int, tab[32]))), SB = __builtin_bit_cast(float, __builtin_amdgcn_readfirstlane(__builtin_bit_cast(int, tab[33])));
    unsigned* qctr = (unsigned*)(ws + WS_MISC + MISC_ATQ) + 64 * (bx & 7);
    volatile LAS int* slot = (volatile LAS int*)(lds + 2 * KT_BYTES + 2 * VT_BYTES);
    const int b = bx & 7;
    int unext = 0; if (tid == 0) unext = (int)atomicAdd(qctr, 1u);
    for (;;) {
        if (tid == 0) *slot = unext;
        __syncthreads();
        const int u = __builtin_amdgcn_readfirstlane(*slot);
        __syncthreads();
        if (u >= 256) break;
        if (tid == 0) unext = (int)atomicAdd(qctr, 1u);
        const int h = 15 - (u >> 4), qb = 15 - (u & 15);
        const float Df = tab[16 + h];
        int tfirst = 0;
        if (Df < 4096.f) { const int kmin = qb * 256 - (int)Df - 1; tfirst = kmin > 0 ? (kmin >> 6) : 0; }
        tfirst = __builtin_amdgcn_readfirstlane(tfirst);
        attn_unit(b, h, qb, Q, K, Vt, Z, P.in[9], lam, lds, tid, wave, lane, tfirst, SB, tab, Df);
    }
}
constexpr size_t MISC_AB = 256 * 1024, MISC_BBT = 512 * 1024, MISC_CMT = 1024 * 1024 + 512 * 1024;
constexpr int HROW = 272;
__device__ __forceinline__ void s5_tables(const Params& P, int gw, int NGW, int lane) {
    unsigned char* ws = P.ws;
    float* AB = (float*)(ws + WS_MISC + MISC_AB); bf16_t* BBT = (bf16_t*)(ws + WS_MISC + MISC_BBT); bf16_t* CMT = (bf16_t*)(ws + WS_MISC + MISC_CMT);
    for (int g = gw; g < 128; g += NGW) {
        const int p = lane;
        const float dt = __expf(P.in[15][g]), lr = P.in[13][g * 64 + p], li = P.in[14][g * 64 + p];
        const float mag = __expf(lr * dt), ar = mag * cosf(li * dt), ai = mag * sinf(li * dt);
        const float den = lr * lr + li * li, nr = ar - 1.f, ni = ai, gr = (nr * lr + ni * li) / den, gi = (ni * lr - nr * li) / den;
        AB[(g * 64 + p) * 2] = ar; AB[(g * 64 + p) * 2 + 1] = ai;
        const int jre = p >> 5, n = p & 31;
#pragma unroll
        for (int c = 0; c < 16; ++c) { const float br = P.in[16][(g * 64 + p) * 16 + c], bi = P.in[17][(g * 64 + p) * 16 + c];
            BBT[((g * 4 + jre) * 32 + n) * 16 + c] = (bf16_t)f2bf(gr * br - gi * bi); BBT[((g * 4 + 2 + jre) * 32 + n) * 16 + c] = (bf16_t)f2bf(gr * bi + gi * br);
            CMT[(g * 16 + c) * 128 + 2 * p] = (bf16_t)f2bf(P.in[18][(g * 16 + c) * 64 + p]); CMT[(g * 16 + c) * 128 + 2 * p + 1] = (bf16_t)f2bf(-P.in[19][(g * 16 + c) * 64 + p]); }
    }
}
constexpr size_t MISC_SEG = 4 * 1024 * 1024;
constexpr int S5_SEGLEN = 512;
template <bool FULL>
__device__ __forceinline__ void s5_pass(const Params& P, LAS unsigned char* lds, int bx, int tid_in) {
    int tid = tid_in; asm volatile("" : "+v"(tid)); const int lane = tid & 63, wave = __builtin_amdgcn_readfirstlane(tid >> 6);
    unsigned char* ws = P.ws;
    const bf16_t* U = (const bf16_t*)(ws + WS_Q); bf16_t* YG = (bf16_t*)(ws + WS_V);
    const float* AB = (const float*)(ws + WS_MISC + MISC_AB); const bf16_t* BBT = (const bf16_t*)(ws + WS_MISC + MISC_BBT); const bf16_t* CMT = (const bf16_t*)(ws + WS_MISC + MISC_CMT);
    f32x4* SEG = (f32x4*)(ws + WS_MISC + MISC_SEG);
    LAS unsigned char* hl = lds + wave * (32 * HROW);
    const int r32 = lane & 31, hi = lane >> 5, l16 = lane & 15, kg = lane >> 4;
    for (int task = bx * NWAVES + wave; task < 4096; task += NWAVES * (int)gridDim.x) {
        const int g = task & 127, bp = (task >> 7) & 3, seg = task >> 9;
        if (!FULL && seg == 7) continue;
        const float ar0 = AB[(g * 64 + r32) * 2], ai0 = AB[(g * 64 + r32) * 2 + 1], ar1 = AB[(g * 64 + 32 + r32) * 2], ai1 = AB[(g * 64 + 32 + r32) * 2 + 1];
        bf16x8 bfr[4], cfr[4];
#pragma unroll
        for (int j = 0; j < 4; ++j) { bfr[j] = *(const bf16x8*)(BBT + ((g * 4 + j) * 32 + r32) * 16 + 8 * hi); if (FULL) cfr[j] = *(const bf16x8*)(CMT + (g * 16 + l16) * 128 + 32 * j + 8 * kg); }
        bf16x8 dh, dl;
        if (FULL) { const float d = P.in[20][g * 16 + l16]; const unsigned h16 = f2bf(d); const unsigned l16b = f2bf(d - __builtin_bit_cast(float, h16 << 16));
#pragma unroll
          for (int i = 0; i < 8; ++i) { const bool on = (kg < 2) && (8 * kg + i == l16); dh[i] = on ? (short)h16 : (short)0; dl[i] = on ? (short)l16b : (short)0; } }
        const int m = r32, bsel = (m >> 2) & 1, tok = (m & 3) + 4 * (m >> 3);
        const int tbeg = seg * S5_SEGLEN;
        const bf16_t* u32p = U + ((size_t)(bp + 4 * bsel) * SEQ + tbeg + tok) * BR + g * 16 + 8 * hi;
        const bf16_t* u16p = U + ((size_t)bp * SEQ + tbeg + l16) * BR + g * 16 + 8 * (kg & 1);
        bf16_t* yp = YG + ((size_t)bp * SEQ + tbeg + 4 * kg) * BR + g * 16 + l16;
        float h0r = 0.f, h0i = 0.f, h1r = 0.f, h1i = 0.f;
        if (FULL && seg > 0) {
            float p0r = ar0, p0i = ai0, p1r = ar1, p1i = ai1;
#pragma unroll
            for (int q = 0; q < 9; ++q) { const float a = p0r * p0r - p0i * p0i, b2 = 2.f * p0r * p0i, c = p1r * p1r - p1i * p1i, d2 = 2.f * p1r * p1i; p0r = a; p0i = b2; p1r = c; p1i = d2; }
            for (int j = 0; j < seg; ++j) { const f32x4 e = SEG[(size_t)(task - (seg - j) * 512) * 64 + lane];
                const float n0r = p0r * h0r - p0i * h0i + e[0], n0i = p0r * h0i + p0i * h0r + e[1], n1r = p1r * h1r - p1i * h1i + e[2], n1i = p1r * h1i + p1i * h1r + e[3];
                h0r = n0r; h0i = n0i; h1r = n1r; h1i = n1i; }
        }
        bf16x8 ua = *(const bf16x8*)u32p, ub0, ub1;
        if (FULL) { ub0 = *(const bf16x8*)u16p; ub1 = *(const bf16x8*)(u16p + (size_t)4 * SEQ * BR); }
        for (int t0 = 0; t0 < S5_SEGLEN; t0 += 16) {
            const bf16x8 ca = ua; bf16x8 cb0, cb1; if (FULL) { cb0 = ub0; cb1 = ub1; }
            if (t0 + 16 < S5_SEGLEN) { const size_t o = (size_t)(t0 + 16) * BR; ua = *(const bf16x8*)(u32p + o); if (FULL) { ub0 = *(const bf16x8*)(u16p + o); ub1 = *(const bf16x8*)(u16p + o + (size_t)4 * SEQ * BR); } }
            if (FULL && kg >= 2) { cb0 = (bf16x8){0, 0, 0, 0, 0, 0, 0, 0}; cb1 = cb0; }
            f32x16 acc[4];
#pragma unroll
            for (int j = 0; j < 4; ++j) {
#pragma unroll
                for (int r = 0; r < 16; ++r) acc[j][r] = 0.f;
                acc[j] = __builtin_amdgcn_mfma_f32_32x32x16_bf16(ca, bfr[j], acc[j], 0, 0, 0); }
#pragma unroll
            for (int r = 0; r < 16; ++r) {
                const float n0r = ar0 * h0r - ai0 * h0i + acc[0][r], n0i = ar0 * h0i + ai0 * h0r + acc[2][r];
                const float n1r = ar1 * h1r - ai1 * h1i + acc[1][r], n1i = ar1 * h1i + ai1 * h1r + acc[3][r];
                h0r = n0r; h0i = n0i; h1r = n1r; h1i = n1i;
                if (FULL) { *(LAS unsigned*)(hl + (16 * hi + r) * HROW + r32 * 4) = cvtpk_s(n0r, n0i);
                    *(LAS unsigned*)(hl + (16 * hi + r) * HROW + (32 + r32) * 4) = cvtpk_s(n1r, n1i); }
            }
            if (FULL) {
#pragma unroll
            for (int blk = 0; blk < 2; ++blk) {
                f32x4 y = (f32x4){0.f, 0.f, 0.f, 0.f};
#pragma unroll
                for (int kk = 0; kk < 4; ++kk) { const bf16x8 hf = *(const LAS bf16x8*)(hl + (16 * blk + l16) * HROW + kk * 64 + kg * 16);
                    y = __builtin_amdgcn_mfma_f32_16x16x32_bf16(hf, cfr[kk], y, 0, 0, 0); }
                y = __builtin_amdgcn_mfma_f32_16x16x32_bf16(blk ? cb1 : cb0, dh, y, 0, 0, 0);
                y = __builtin_amdgcn_mfma_f32_16x16x32_bf16(blk ? cb1 : cb0, dl, y, 0, 0, 0);
                bf16_t* o = yp + ((size_t)(4 * blk) * SEQ + t0) * BR;
                const unsigned w01 = cvtpk_s(gelu_tanh(y[0]), gelu_tanh(y[1])), w23 = cvtpk_s(gelu_tanh(y[2]), gelu_tanh(y[3]));
                o[0] = (bf16_t)(w01 & 0xffffu); o[(size_t)BR] = (bf16_t)(w01 >> 16); o[(size_t)2 * BR] = (bf16_t)(w23 & 0xffffu); o[(size_t)3 * BR] = (bf16_t)(w23 >> 16);
            }
            }
        }
        if (!FULL) SEG[(size_t)task * 64 + lane] = (f32x4){h0r, h0i, h1r, h1i};
    }
}
__global__ void __launch_bounds__(NTHREADS, 2) fwd_mega(Params P) {
    extern __shared__ __attribute__((aligned(16))) unsigned char lds_raw[];
    LAS unsigned char* lds = (LAS unsigned char*)lds_raw;
    const int G = gridDim.x, bx = blockIdx.x, NGW = G * NWAVES;
    const int wave_s = __builtin_amdgcn_readfirstlane((int)threadIdx.x >> 6);
    unsigned* gbar_base = (unsigned*)(P.ws + WS_MISC + 160 * 1024); unsigned gbar_k = 0;
    const unsigned gbar_ng = G < 8 ? (unsigned)G : 8u, gbar_nx = (unsigned)(G - (bx & 7) + 7) >> 3;
#define GRID_BAR() do { ++gbar_k; __syncthreads(); if (MYTID == 0) { __threadfence(); \
        if (atomicAdd(gbar_base + 64 * (bx & 7), 1u) == gbar_k * gbar_nx - 1u) atomicAdd(gbar_base + 64 * 8, 1u); \
        while (__hip_atomic_load(gbar_base + 64 * 8, __ATOMIC_RELAXED, __HIP_MEMORY_SCOPE_AGENT) < gbar_k * gbar_ng) __builtin_amdgcn_s_sleep(1); \
        __threadfence(); } __syncthreads(); } while (0)
#define MYTID (wave_s * 64 + (int)__builtin_amdgcn_mbcnt_hi(~0u, __builtin_amdgcn_mbcnt_lo(~0u, 0u)))
#define PHASE_IDS int tid = MYTID; asm volatile("" : "+v"(tid)); const int lane = tid & 63, wave = __builtin_amdgcn_readfirstlane(tid >> 6), gw = bx * NWAVES + wave; (void)gw; (void)lane
    unsigned char* ws = P.ws;
    bf16_t* XN = (bf16_t*)(ws + WS_XN); bf16_t* Qb = (bf16_t*)(ws + WS_Q); bf16_t* Kb = (bf16_t*)(ws + WS_K); bf16_t* Vb = (bf16_t*)(ws + WS_V);
    float* rowss = (float*)(ws + WS_MISC + MISC_ROWSS);

    { PHASE_IDS; prologue(P, lds, gw, NGW, wave, lane); s5_tables(P, gw, NGW, lane); }
    cg::this_grid().sync();
    {
        {
            pg8::Gemm g{XN, (const bf16_t*)(ws + WS_W0), MT, 4096, DM}; pg8::StaticOrder S; S.init(MT, 4096, G, bx);
            EpiQKZ E{Qb, Kb, (bf16_t*)P.out, P.in[3], P.in[4], 0};
            pg8::gemm_phase<EpiQKZ, pg8::StaticOrder, true, true>(lds, g, S, E, MYTID);
            pg8::Gemm gz{XN, (const bf16_t*)(ws + WS_W0) + (size_t)4096 * DM, MT, 2048, DM}; pg8::StaticOrder Sz; Sz.init(MT, 2048, G, bx);
            EpiQKZ Ez{Qb, Kb, (bf16_t*)P.out, P.in[3], P.in[4], 16};
            pg8::gemm_phase<EpiQKZ, pg8::StaticOrder, true, true>(lds, gz, Sz, Ez, MYTID);
        }
        pg8::Gemm g2{(const bf16_t*)(ws + WS_W0) + (size_t)6144 * DM, XN, BR, MT, DM}; pg8::StaticOrder S2; S2.init(BR, MT, G, bx);
        EpiVt E2{Vb};
        pg8::gemm_phase<EpiVt, pg8::StaticOrder, true, true>(lds, g2, S2, E2, MYTID);
    }
    GRID_BAR();
    attn_phase(P, lds, bx, MYTID);
    GRID_BAR();
    {
        pg8::Gemm g{Qb, (const bf16_t*)(ws + WS_WO0), MT, DM, BR}; pg8::StaticOrder S; S.init(MT, DM, G, bx);
        EpiWo0 E{P.in[0], P.out, XN, rowss};
        pg8::gemm_phase<EpiWo0, pg8::StaticOrder, true, true>(lds, g, S, E, MYTID);
    }
    GRID_BAR();
    {
        pg8::Gemm g{XN, (const bf16_t*)(ws + WS_W1), MT, 2 * BR, DM}; pg8::StaticOrder S; S.init(MT, 2 * BR, G, bx);
        EpiUZ E{Qb, Kb, rowss};
        pg8::gemm_phase<EpiUZ, pg8::StaticOrder, true, true>(lds, g, S, E, MYTID);
    }
    GRID_BAR();
    s5_pass<false>(P, lds, bx, MYTID);
    GRID_BAR();
    s5_pass<true>(P, lds, bx, MYTID);
    GRID_BAR();
    {
        pg8::Gemm g{Vb, (const bf16_t*)(ws + WS_WG), MT, BR, BR}; pg8::StaticOrder S; S.init(MT, BR, G, bx);
        EpiGLU E{Vb, Kb, Qb, P.in[22]};
        pg8::gemm_phase<EpiGLU, pg8::StaticOrder, true, true>(lds, g, S, E, MYTID);
    }
    GRID_BAR();
    {
        pg8::Gemm g{Qb, (const bf16_t*)(ws + WS_WO1), MT, DM, BR}; pg8::StaticOrder S; S.init(MT, DM, G, bx);
        EpiOut E{P.out, XN};
        pg8::gemm_phase<EpiOut, pg8::StaticOrder, true, true>(lds, g, S, E, MYTID);
    }
}

extern "C" void kernel_launch(void* const* d_in, const int* in_sizes, int n_in, void* d_out, int out_size, void* d_ws, size_t ws_size, hipStream_t stream) {
    static int grid = 0;
    if (grid == 0) {
        if (n_in != 24 || out_size != MT * DM || ws_size < WS_END) { fprintf(stderr, "kernel_launch: unexpected shapes n_in %d out %d ws %zu\n", n_in, out_size, ws_size); grid = -1; return; }
        int dev = 0, cus = 0, per_cu = 0;
        hipGetDevice(&dev); hipDeviceGetAttribute(&cus, hipDeviceAttributeMultiprocessorCount, dev);
        if (hipFuncSetAttribute((const void*)fwd_mega, hipFuncAttributeMaxDynamicSharedMemorySize, LDS_BYTES) != hipSuccess) { fprintf(stderr, "kernel_launch: hipFuncSetAttribute failed\n"); grid = -1; return; }
        if (hipOccupancyMaxActiveBlocksPerMultiprocessor(&per_cu, (const void*)fwd_mega, NTHREADS, LDS_BYTES) != hipSuccess || per_cu < 1) { fprintf(stderr, "kernel_launch: occupancy query says %d\n", per_cu); grid = -1; return; }
        grid = cus;
    }
    if (grid < 0) return;
    Params p{};
    for (int i = 0; i < 24; ++i) p.in[i] = (const float*)d_in[i];
    p.out = (float*)d_out; p.ws = (unsigned char*)d_ws;
    void* args[] = {&p};
    hipError_t e = hipLaunchCooperativeKernel((const void*)fwd_mega, dim3(grid), dim3(NTHREADS), args, LDS_BYTES, stream);
    if (e != hipSuccess) fprintf(stderr, "cooperative launch failed: %s (grid %d)\n", hipGetErrorString(e), grid);

}
```

```cpp
#include <hip/hip_runtime.h>
#include <hip/hip_cooperative_groups.h>
#include <cstdio>
#include <cstdint>
namespace cg = cooperative_groups;
namespace pg8 {
#define PG8_LAS __attribute__((address_space(3)))
typedef unsigned short bf16_t;
typedef short bf16x8 __attribute__((ext_vector_type(8)));
typedef float f32x4 __attribute__((ext_vector_type(4)));
typedef unsigned u32x4 __attribute__((ext_vector_type(4)));
constexpr int BM = 256, BK = 64, HALF = 128, HTB = HALF * BK * 2  , STAGE_BYTES = 8 * HTB, NXCD = 8, WGM = 4;

__host__ __device__ __forceinline__ int lds_byte(int r, int c) { const int st = (r >> 4) * 2 + (c >> 5), rr = r & 15, cc = c & 31, ob = rr * 64 + cc * 2; return st * 1024 + (ob ^ (((ob >> 9) & 1) << 5)); }
__host__ __device__ __forceinline__ void stage_rc(int b, int& R, int& C) { const int st = b / 1024, sb = b % 1024, swz = sb ^ (((sb >> 9) & 1) << 5); R = (st >> 1) * 16 + swz / 64; C = (st & 1) * 32 + (swz % 64) / 2; }
__host__ __device__ __forceinline__ int perm32(int rho) { const int n = rho >> 4, i = rho & 15; return 8 * (i >> 2) + 4 * n + (i & 3); }

struct Unit { int pm, pn; };
struct Gemm { const bf16_t* A; const bf16_t* Bt; int M, N, K; };

struct StaticOrder {
    int nM, nN, nwg, G, c;
    __host__ __device__ void init(int M, int N, int G_, int c_) { nM = M / BM; nN = N / BM; nwg = nM * nN; G = G_; c = c_; }
    __host__ __device__ bool next(int i, Unit& u) const {
        const long L = (long)i * G + c; if (L >= nwg) return false;
        int wgid = (int)L; { const int q = nwg / NXCD, r = nwg % NXCD, xcd = wgid % NXCD, off = wgid / NXCD; wgid = (xcd < r ? xcd * (q + 1) : r * (q + 1) + (xcd - r) * q) + off; }
        const int nig = WGM * nN, gid = wgid / nig, fm = gid * WGM, gsz = (nM - fm) < WGM ? (nM - fm) : WGM;
        u.pm = fm + ((wgid % nig) % gsz); u.pn = (wgid % nig) / gsz; return true;
    }
    __device__ __forceinline__ void a_ready(const Unit&) const {}
    __device__ __forceinline__ void done(const Unit&) const {}
};

__device__ __forceinline__ unsigned cvt_pk_bf16(float lo, float hi) { unsigned r; asm volatile("v_cvt_pk_bf16_f32 %0, %1, %2" : "=v"(r) : "v"(lo), "v"(hi)); return r; }
template <class Epi, class Sched, bool ALIGN_EPI = false, bool SP2 = false>
__device__ __forceinline__ void gemm_phase(PG8_LAS unsigned char* lds, const Gemm g, const Sched& S, const Epi& E, int tid_in) {
    int tid = tid_in; asm volatile("" : "+v"(tid));
    const int wid = __builtin_amdgcn_readfirstlane(tid >> 6), lane = tid & 63, wr = wid >> 2, wc = wid & 3, fr = lane & 15, fq = lane >> 4;
    const int K = g.K, nt = K / BK;
    unsigned voffA[2], voffB[2];
#pragma unroll
    for (int i = 0; i < 2; ++i) { int R, C; stage_rc(tid * 16 + i * 8192, R, C); const int Rb = Epi::PERM ? ((R & ~31) + perm32(R & 31)) : R;
        voffA[i] = (unsigned)(R * K + C) * 2u; voffB[i] = (unsigned)(Rb * K + C) * 2u; }
    const size_t kstep = (size_t)(BK * 2);
    const size_t hstep = (size_t)HALF * K * 2;
    const size_t tstep = 2 * hstep;
    const unsigned ldsw = (unsigned)wid * 1024u;
    const int aoff = lds_byte(wr * 64 + fr, fq * 8), boff = lds_byte(wc * 32 + fr, fq * 8);
#define PG8_SA(b, h) (((b) * 2 + (h)) * HTB)
#define PG8_SB(b, h) ((4 + (b) * 2 + (h)) * HTB)
#define PG8_STAGE(bufoff, gbase, voff) do { _Pragma("unroll") for (int _i = 0; _i < 2; ++_i) \
        __builtin_amdgcn_global_load_lds((const unsigned*)((const char*)(gbase) + (voff)[_i]), (PG8_LAS unsigned*)(lds + (bufoff) + ldsw + _i * 8192), 16, 0, 0); } while (0)
#define PG8_LDA(dst, b, h) do { _Pragma("unroll") for (int m = 0; m < 4; ++m) _Pragma("unroll") for (int k = 0; k < 2; ++k) dst[m][k] = *(const PG8_LAS bf16x8*)(lds + PG8_SA(b, h) + aoff + m * 2048 + k * 1024); } while (0)
#define PG8_LDB(dst, b, h) do { _Pragma("unroll") for (int n = 0; n < 2; ++n) _Pragma("unroll") for (int k = 0; k < 2; ++k) dst[n][k] = *(const PG8_LAS bf16x8*)(lds + PG8_SB(b, h) + boff + n * 2048 + k * 1024); } while (0)
#define PG8_MMA(ai, bj, At, Bt) do { __builtin_amdgcn_s_setprio(1); _Pragma("unroll") for (int m = 0; m < 4; ++m) _Pragma("unroll") for (int n = 0; n < 2; ++n) _Pragma("unroll") for (int k = 0; k < 2; ++k) \
        acc[ai][bj][m][n] = __builtin_amdgcn_mfma_f32_16x16x32_bf16(Bt[n][k], At[m][k], acc[ai][bj][m][n], 0, 0, 0); __builtin_amdgcn_s_setprio(0); } while (0)
#define PG8_WAIT_V(n) asm volatile("s_waitcnt vmcnt(" #n ")" ::: "memory")
#define PG8_WAIT_L(n) asm volatile("s_waitcnt lgkmcnt(" #n ")" ::: "memory")
#define PG8_BAR __builtin_amdgcn_s_barrier()
#define PG8_SCHED __builtin_amdgcn_sched_barrier(0)
    Unit cur, nxt; int ui = 0;
    if (!S.next(0, cur)) return;
    f32x4 acc[2][2][4][2];
#pragma unroll
    for (int a = 0; a < 2; ++a)
#pragma unroll
        for (int b = 0; b < 2; ++b)
#pragma unroll
            for (int m = 0; m < 4; ++m)
#pragma unroll
                for (int n = 0; n < 2; ++n) acc[a][b][m][n] = (f32x4){0.f, 0.f, 0.f, 0.f};
    bf16x8 At[4][2], B0[2][2], B1[2][2];
    const char* cA = (const char*)g.A + (size_t)cur.pm * tstep; const char* cB = (const char*)g.Bt + (size_t)cur.pn * tstep;
    S.a_ready(cur);
    if constexpr (SP2) {
        PG8_STAGE(PG8_SB(0, 0), cB, voffB); PG8_STAGE(PG8_SB(0, 1), cB + hstep, voffB); PG8_STAGE(PG8_SA(0, 0), cA, voffA); PG8_STAGE(PG8_SA(0, 1), cA + hstep, voffA);
        if (wr == 1) PG8_BAR;
        PG8_WAIT_V(2); PG8_BAR;
        PG8_STAGE(PG8_SB(1, 0), cB + kstep, voffB); PG8_STAGE(PG8_SA(1, 0), cA + kstep, voffA); PG8_STAGE(PG8_SB(1, 1), cB + hstep + kstep, voffB);
        PG8_WAIT_V(6); PG8_BAR;
    } else {
        PG8_STAGE(PG8_SB(0, 0), cB, voffB); PG8_STAGE(PG8_SA(0, 0), cA, voffA); PG8_STAGE(PG8_SB(0, 1), cB + hstep, voffB); PG8_STAGE(PG8_SA(0, 1), cA + hstep, voffA);
        if (wr == 1) PG8_BAR;
        PG8_WAIT_V(4); PG8_BAR;
        PG8_STAGE(PG8_SB(1, 0), cB + kstep, voffB); PG8_STAGE(PG8_SA(1, 0), cA + kstep, voffA); PG8_STAGE(PG8_SB(1, 1), cB + hstep + kstep, voffB);
        PG8_WAIT_V(6); PG8_BAR;
    }
    for (;;) {
        const bool has_next = S.next(ui + 1, nxt);
        const char* nA = has_next ? (const char*)g.A + (size_t)nxt.pm * tstep : cA; const char* nB = has_next ? (const char*)g.Bt + (size_t)nxt.pn * tstep : cB;
        for (int t = 0; t < nt; t += 2) {
            const bool last = (t == nt - 2);
            const char* a1 = cA + (size_t)(t + 1) * kstep;
            const char* a2 = last ? nA : cA + (size_t)(t + 2) * kstep; const char* b2 = last ? nB : cB + (size_t)(t + 2) * kstep;
            const char* a3 = a2 + kstep; const char* b3 = b2 + kstep;
            if (last && has_next) S.a_ready(nxt);
            if constexpr (SP2) {
            PG8_LDB(B0, 0, 0); PG8_LDB(B1, 0, 1); PG8_SCHED; PG8_LDA(At, 0, 0); PG8_STAGE(PG8_SA(1, 1), a1 + hstep, voffA);
            PG8_WAIT_V(8); PG8_WAIT_L(0); PG8_BAR; PG8_MMA(0, 0, At, B0); PG8_MMA(0, 1, At, B1); PG8_BAR; PG8_SCHED;
            PG8_LDA(At, 0, 1); PG8_STAGE(PG8_SB(0, 0), b2, voffB); PG8_STAGE(PG8_SB(0, 1), b2 + hstep, voffB); PG8_STAGE(PG8_SA(0, 0), a2, voffA);
            PG8_WAIT_V(8); PG8_WAIT_L(0); PG8_BAR; PG8_MMA(1, 0, At, B0); PG8_MMA(1, 1, At, B1); PG8_BAR; PG8_SCHED;
            PG8_LDB(B0, 1, 0); PG8_LDB(B1, 1, 1); PG8_SCHED; PG8_LDA(At, 1, 0); PG8_STAGE(PG8_SA(0, 1), a2 + hstep, voffA);
            PG8_WAIT_V(8); PG8_WAIT_L(0); PG8_BAR; PG8_MMA(0, 0, At, B0); PG8_MMA(0, 1, At, B1); PG8_BAR; PG8_SCHED;
            PG8_LDA(At, 1, 1); PG8_STAGE(PG8_SB(1, 0), b3, voffB); PG8_STAGE(PG8_SB(1, 1), b3 + hstep, voffB); PG8_STAGE(PG8_SA(1, 0), a3, voffA);
            PG8_WAIT_V(8); PG8_WAIT_L(0); PG8_BAR; PG8_MMA(1, 0, At, B0); PG8_MMA(1, 1, At, B1); PG8_BAR; PG8_SCHED;
            } else {
            PG8_LDB(B0, 0, 0); PG8_SCHED; PG8_LDA(At, 0, 0); PG8_STAGE(PG8_SA(1, 1), a1 + hstep, voffA);
            PG8_WAIT_L(8); PG8_BAR; PG8_WAIT_L(0); PG8_MMA(0, 0, At, B0); PG8_BAR; PG8_SCHED;
            PG8_LDB(B1, 0, 1); PG8_STAGE(PG8_SB(0, 0), b2, voffB);
            PG8_BAR; PG8_WAIT_L(0); PG8_MMA(0, 1, At, B1); PG8_BAR;
            PG8_LDA(At, 0, 1); PG8_STAGE(PG8_SA(0, 0), a2, voffA);
            PG8_BAR; PG8_WAIT_L(0); PG8_MMA(1, 0, At, B0); PG8_BAR; PG8_SCHED;
            PG8_STAGE(PG8_SB(0, 1), b2 + hstep, voffB);
            PG8_WAIT_V(6); PG8_BAR; PG8_MMA(1, 1, At, B1); PG8_BAR;
            PG8_LDB(B0, 1, 0); PG8_SCHED; PG8_LDA(At, 1, 0); PG8_STAGE(PG8_SA(0, 1), a2 + hstep, voffA);
            PG8_WAIT_L(8); PG8_BAR; PG8_WAIT_L(0); PG8_MMA(0, 0, At, B0); PG8_BAR; PG8_SCHED;
            PG8_LDB(B1, 1, 1); PG8_STAGE(PG8_SB(1, 0), b3, voffB);
            PG8_BAR; PG8_WAIT_L(0); PG8_MMA(0, 1, At, B1); PG8_BAR;
            PG8_LDA(At, 1, 1); PG8_STAGE(PG8_SA(1, 0), a3, voffA);
            PG8_BAR; PG8_WAIT_L(0); PG8_MMA(1, 0, At, B0); PG8_BAR; PG8_SCHED;
            PG8_STAGE(PG8_SB(1, 1), b3 + hstep, voffB);
            PG8_WAIT_V(6); PG8_BAR; PG8_MMA(1, 1, At, B1); PG8_BAR;
            }
        }
        if constexpr (ALIGN_EPI) { if (wr == 0) PG8_BAR; }
        if constexpr (!Epi::AFTER_DRAIN) { E(acc, cur, wr, wc, fr, fq); S.done(cur); }
        if (!has_next) break;
#pragma unroll
        for (int a = 0; a < 2; ++a)
#pragma unroll
            for (int b = 0; b < 2; ++b)
#pragma unroll
                for (int m = 0; m < 4; ++m)
#pragma unroll
                    for (int n = 0; n < 2; ++n) acc[a][b][m][n] = (f32x4){0.f, 0.f, 0.f, 0.f};
        cur = nxt; cA = nA; cB = nB; ++ui;
        if constexpr (ALIGN_EPI) { if (wr == 1) PG8_BAR; }
    }
    PG8_WAIT_V(0);
    if constexpr (!ALIGN_EPI) { if (wr == 0) PG8_BAR; }
    PG8_BAR;
    if constexpr (Epi::AFTER_DRAIN) { E.fused(acc, cur, wr, wc, fr, fq, lds, wid, lane); S.done(cur); }
#undef PG8_SA
#undef PG8_SB
#undef PG8_STAGE
#undef PG8_LDA
#undef PG8_LDB
#undef PG8_MMA
#undef PG8_WAIT_V
#undef PG8_WAIT_L
#undef PG8_BAR
#undef PG8_SCHED
}
}
using pg8::bf16_t; using pg8::f32x4; using pg8::u32x4; using pg8::Unit;
#define LAS __attribute__((address_space(3)))
constexpr int NB = 8, SEQ = 4096, DM = 1024, BR = 2048, MT = NB * SEQ, NH = 16;
constexpr float EPS = 1e-6f, LOG2E = 1.4426950408889634f, C2 = 0.125f * LOG2E, LAM0 = 0.2f;
constexpr size_t MiB = 1u << 20;
constexpr size_t WS_W0 = 0, WS_WO0 = 16 * MiB, WS_W1 = 20 * MiB, WS_WG = 28 * MiB, WS_WO1 = 36 * MiB, WS_XN = 40 * MiB;
constexpr size_t WS_Q = 104 * MiB, WS_K = 232 * MiB, WS_V = 360 * MiB, WS_MISC = 488 * MiB, WS_END = 512 * MiB;
constexpr size_t MISC_ROWSS = 0;
constexpr int LDS_BYTES = 147456;
constexpr int NTHREADS = 512, NWAVES = 8;

__device__ __forceinline__ unsigned f2bf(float f) { unsigned u = __builtin_bit_cast(unsigned, f); return (u + 0x7fffu + ((u >> 16) & 1u)) >> 16; }
__device__ __forceinline__ unsigned pk2(float lo, float hi) { return pg8::cvt_pk_bf16(lo, hi); }
__device__ __forceinline__ float bflo(unsigned u) { return __builtin_bit_cast(float, u << 16); }
__device__ __forceinline__ float bfhi(unsigned u) { return __builtin_bit_cast(float, u & 0xffff0000u); }
__device__ __forceinline__ float bf1(bf16_t h) { return __builtin_bit_cast(float, (unsigned)h << 16); }
__device__ __forceinline__ float wave_sum(float v) {
#pragma unroll
    for (int o = 1; o < 64; o <<= 1) v += __shfl_xor(v, o);
    return v;
}
__device__ __forceinline__ float wave_max(float v) {
#pragma unroll
    for (int o = 1; o < 64; o <<= 1) v = fmaxf(v, __shfl_xor(v, o));
    return v;
}
__device__ __forceinline__ float sigmoidf_(float v) { return __builtin_amdgcn_rcpf(1.f + __builtin_amdgcn_exp2f(-LOG2E * v)); }
__device__ __forceinline__ float siluf_(float v) { return v * __builtin_amdgcn_rcpf(1.f + __builtin_amdgcn_exp2f(-LOG2E * v)); }
__device__ __forceinline__ float gelu_tanh(float y) { const float t = (-1.5957691216057308f * LOG2E) * (y + 0.044715f * y * y * y); return y * __builtin_amdgcn_rcpf(1.f + __builtin_amdgcn_exp2f(t)); }
__device__ __forceinline__ u32x4 pack8(const f32x4& a, const f32x4& b) { u32x4 w; w.x = pk2(a[0], a[1]); w.y = pk2(a[2], a[3]); w.z = pk2(b[0], b[1]); w.w = pk2(b[2], b[3]); return w; }

struct Params {
    const float* in[24]; float* out; unsigned char* ws;
};

typedef f32x4 AccT[2][2][4][2];
struct EpiQKZ {
    static constexpr bool PERM = true, AFTER_DRAIN = false;
    bf16_t *Q, *K, *Z; const float *gq, *gk; int pn_off;
    __device__ __forceinline__ void operator()(const AccT& acc, const Unit& u, int wr, int wc, int fr, int fq) const {
        const int kind = (u.pn + pn_off) >> 3, tile = (u.pn + pn_off) & 7;
        bf16_t* base = Q + (size_t)kind * ((WS_K - WS_Q) / 2); if (kind == 2) base = Z;
        const float* g = gq; if (kind == 1) g = gk; const float gs = kind == 0 ? C2 : 1.f;
        f32x4 gv[2][2];
#pragma unroll
        for (int bj = 0; bj < 2; ++bj)
#pragma unroll
            for (int n = 0; n < 2; ++n) gv[bj][n] = (kind < 2) ? *(const f32x4*)(g + 32 * bj + 8 * fq + 4 * n) * gs : (f32x4){1.f, 1.f, 1.f, 1.f};
        const int row0 = u.pm * 256 + wr * 64 + fr;
#pragma unroll
        for (int ai = 0; ai < 2; ++ai)
#pragma unroll
            for (int m = 0; m < 4; ++m) {
                const int row = row0 + ai * 128 + m * 16; float rs = 1.f;
                if (kind < 2) { float ss = 0.f;
#pragma unroll
                    for (int bj = 0; bj < 2; ++bj)
#pragma unroll
                        for (int n = 0; n < 2; ++n) { const f32x4 v = acc[ai][bj][m][n]; ss += (v[0] * v[0] + v[1] * v[1]) + (v[2] * v[2] + v[3] * v[3]); }
                    ss += __shfl_xor(ss, 16); ss += __shfl_xor(ss, 32); rs = rsqrtf(ss * (1.f / 64.f) + EPS); }
                bf16_t* rp = base + (size_t)row * BR + tile * 256 + 64 * wc + 8 * fq;
#pragma unroll
                for (int bj = 0; bj < 2; ++bj) { const f32x4 v0 = acc[ai][bj][m][0] * rs * gv[bj][0], v1 = acc[ai][bj][m][1] * rs * gv[bj][1];
                    __builtin_nontemporal_store(pack8(v0, v1), (u32x4*)(rp + 32 * bj)); }
            }
    }
};
struct EpiVt {
    static constexpr bool PERM = true, AFTER_DRAIN = false;
    bf16_t* Vt;
    __device__ __forceinline__ void operator()(const AccT& acc, const Unit& u, int wr, int wc, int fr, int fq) const {
        const int b = u.pn >> 4, s0 = (u.pn & 15) * 256 + wc * 32 + 8 * fq, vrow0 = u.pm * 256 + wr * 64 + fr;
#pragma unroll
        for (int ai = 0; ai < 2; ++ai)
#pragma unroll
            for (int m = 0; m < 4; ++m) { bf16_t* rp = Vt + ((size_t)(b * BR + vrow0 + ai * 128 + m * 16)) * SEQ + s0;
#pragma unroll
                for (int bj = 0; bj < 2; ++bj) __builtin_nontemporal_store(pack8(acc[ai][bj][m][0], acc[ai][bj][m][1]), (u32x4*)(rp + bj * 128)); }
    }
};
struct EpiWo0 {
    static constexpr bool PERM = true, AFTER_DRAIN = false;
    const float* x; float* x1; bf16_t* xb; float* rowss;
    __device__ __forceinline__ void operator()(const AccT& acc, const Unit& u, int wr, int wc, int fr, int fq) const {
        const int row0 = u.pm * 256 + wr * 64 + fr, col0 = u.pn * 256 + wc * 32 + 8 * fq;
#pragma unroll
        for (int ai = 0; ai < 2; ++ai)
#pragma unroll
            for (int m = 0; m < 4; ++m) { const int row = row0 + ai * 128 + m * 16; float ss = 0.f;
#pragma unroll
                for (int bj = 0; bj < 2; ++bj) { const size_t o = (size_t)row * DM + col0 + bj * 128;
                    const f32x4 v0 = acc[ai][bj][m][0] + *(const f32x4*)(x + o), v1 = acc[ai][bj][m][1] + *(const f32x4*)(x + o + 4);
                    *(u32x4*)(xb + o) = pack8(v0, v1);
                    ss += (v0[0] * v0[0] + v0[1] * v0[1]) + (v0[2] * v0[2] + v0[3] * v0[3]) + (v1[0] * v1[0] + v1[1] * v1[1]) + (v1[2] * v1[2] + v1[3] * v1[3]); }
                ss += __shfl_xor(ss, 16); ss += __shfl_xor(ss, 32);
                if (fq == 0) atomicAdd(rowss + row, ss); }
    }
};
struct EpiUZ {
    static constexpr bool PERM = true, AFTER_DRAIN = false;
    bf16_t *U, *Zs; const float* rowss;
    __device__ __forceinline__ void operator()(const AccT& acc, const Unit& u, int wr, int wc, int fr, int fq) const {
        const int kind = u.pn >> 3, tile = u.pn & 7; bf16_t* base = kind ? Zs : U;
        const int row0 = u.pm * 256 + wr * 64 + fr, col0 = tile * 256 + wc * 32 + 8 * fq;
#pragma unroll
        for (int ai = 0; ai < 2; ++ai)
#pragma unroll
            for (int m = 0; m < 4; ++m) { const int row = row0 + ai * 128 + m * 16; const float rs = rsqrtf(rowss[row] * (1.f / DM) + EPS);
#pragma unroll
                for (int bj = 0; bj < 2; ++bj) { f32x4 v0 = acc[ai][bj][m][0] * rs, v1 = acc[ai][bj][m][1] * rs;
                    if (kind) {
#pragma unroll
                        for (int j = 0; j < 4; ++j) { v0[j] = siluf_(v0[j]); v1[j] = siluf_(v1[j]); } }
                    __builtin_nontemporal_store(pack8(v0, v1), (u32x4*)(base + (size_t)row * BR + col0 + bj * 128)); } }
    }
};
struct EpiGLU {
    static constexpr bool PERM = true, AFTER_DRAIN = false;
    const bf16_t *YG, *Zs; bf16_t* YZ; const float* bias;
    __device__ __forceinline__ void operator()(const AccT& acc, const Unit& u, int wr, int wc, int fr, int fq) const {
        const int row0 = u.pm * 256 + wr * 64 + fr, col0 = u.pn * 256 + wc * 32 + 8 * fq;
#pragma unroll
        for (int bj = 0; bj < 2; ++bj) { const int c = col0 + bj * 128; const f32x4 b0 = *(const f32x4*)(bias + c), b1 = *(const f32x4*)(bias + c + 4);
#pragma unroll
            for (int ai = 0; ai < 2; ++ai)
#pragma unroll
                for (int m = 0; m < 4; ++m) { const size_t o = (size_t)(row0 + ai * 128 + m * 16) * BR + c;
                    const u32x4 y8 = *(const u32x4*)(YG + o), z8 = *(const u32x4*)(Zs + o);
                    const f32x4 g0 = acc[ai][bj][m][0] + b0, g1 = acc[ai][bj][m][1] + b1; f32x4 v0, v1;
                    v0[0] = bflo(y8.x) * bflo(z8.x) * sigmoidf_(g0[0]); v0[1] = bfhi(y8.x) * bfhi(z8.x) * sigmoidf_(g0[1]);
                    v0[2] = bflo(y8.y) * bflo(z8.y) * sigmoidf_(g0[2]); v0[3] = bfhi(y8.y) * bfhi(z8.y) * sigmoidf_(g0[3]);
                    v1[0] = bflo(y8.z) * bflo(z8.z) * sigmoidf_(g1[0]); v1[1] = bfhi(y8.z) * bfhi(z8.z) * sigmoidf_(g1[1]);
                    v1[2] = bflo(y8.w) * bflo(z8.w) * sigmoidf_(g1[2]); v1[3] = bfhi(y8.w) * bfhi(z8.w) * sigmoidf_(g1[3]);
                    *(u32x4*)(YZ + o) = pack8(v0, v1); } }
    }
};
struct EpiOut {
    static constexpr bool PERM = true, AFTER_DRAIN = false;
    float* out; const bf16_t* xb;
    __device__ __forceinline__ void operator()(const AccT& acc, const Unit& u, int wr, int wc, int fr, int fq) const {
        const int row0 = u.pm * 256 + wr * 64 + fr, col0 = u.pn * 256 + wc * 32 + 8 * fq;
#pragma unroll
        for (int ai = 0; ai < 2; ++ai)
#pragma unroll
            for (int m = 0; m < 4; ++m)
#pragma unroll
                for (int bj = 0; bj < 2; ++bj) { const size_t o = (size_t)(row0 + ai * 128 + m * 16) * DM + col0 + bj * 128; float* p = out + o;
                    const u32x4 x8 = *(const u32x4*)(xb + o);
                    const f32x4 v0 = acc[ai][bj][m][0] + (f32x4){bflo(x8.x), bfhi(x8.x), bflo(x8.y), bfhi(x8.y)}, v1 = acc[ai][bj][m][1] + (f32x4){bflo(x8.z), bfhi(x8.z), bflo(x8.w), bfhi(x8.w)};
                    __builtin_nontemporal_store(v0, (f32x4*)p); __builtin_nontemporal_store(v1, (f32x4*)(p + 4)); }
    }
};
__device__ __forceinline__ void tr_item(const float* W, int N, int K, bf16_t* WT, int n0, int k0, int drow0, const float* kscale, LAS float* scr, int lane) {
    float tv[32];
#pragma unroll
    for (int i = 0; i < 32; ++i) tv[i] = __builtin_nontemporal_load(W + (size_t)(k0 + 2 * i + (lane >> 5)) * N + n0 + (lane & 31));
#pragma unroll
    for (int i = 0; i < 32; ++i) { const int kk = 2 * i + (lane >> 5); float v = tv[i]; if (kscale) v *= kscale[k0 + kk]; scr[kk * 33 + (lane & 31)] = v; }
    asm volatile("s_waitcnt lgkmcnt(0)" ::: "memory");
    const int c = lane & 7;
#pragma unroll
    for (int j = 0; j < 4; ++j) { const int n = (lane >> 3) + 8 * j; const LAS float* s = scr + (8 * c) * 33 + n;
        u32x4 o; o.x = pk2(s[0 * 33], s[1 * 33]); o.y = pk2(s[2 * 33], s[3 * 33]); o.z = pk2(s[4 * 33], s[5 * 33]); o.w = pk2(s[6 * 33], s[7 * 33]);
        *(u32x4*)(WT + (size_t)(drow0 + n) * K + k0 + 8 * c) = o; }
    asm volatile("s_waitcnt lgkmcnt(0)" ::: "memory");
}
__device__ __forceinline__ int map_w0(int n0) {
    const int sec = n0 >> 11, r = n0 & 2047;
    if (sec == 2) return 6144 + r;
    const int tile = r >> 8, L = r & 255, wcg = L >> 6, bjg = (L & 63) >> 5, p = 128 * bjg + 32 * wcg;
    const int base = sec == 0 ? 0 : (sec == 1 ? 2048 : 4096);
    return base + 256 * tile + p;
}
__device__ __forceinline__ void prologue(const Params& P, LAS unsigned char* lds, int gw, int NGW, int wave, int lane) {
    unsigned char* ws = P.ws;
    LAS float* scr = (LAS float*)(lds + wave * 16384);
    constexpr int I0 = (DM / 64) * (4 * BR / 32), IO = (BR / 64) * (DM / 32), I1 = (DM / 64) * (2 * BR / 32), IG = (BR / 64) * (BR / 32);
    constexpr int NIT = I0 + IO + I1 + IG + IO;
    for (int it = gw; it < NIT; it += NGW) {
        int r = it;
        if (r < I0) { const int nblk = 4 * BR / 32, kb = r / nblk, nb = r % nblk; tr_item(P.in[2], 4 * BR, DM, (bf16_t*)(ws + WS_W0), 32 * nb, 64 * kb, map_w0(32 * nb), nullptr, scr, lane); continue; } r -= I0;
        if (r < IO) { const int nblk = DM / 32, kb = r / nblk, nb = r % nblk; tr_item(P.in[10], DM, BR, (bf16_t*)(ws + WS_WO0), 32 * nb, 64 * kb, 32 * nb, nullptr, scr, lane); continue; } r -= IO;
        if (r < I1) { const int nblk = 2 * BR / 32, kb = r / nblk, nb = r % nblk; tr_item(P.in[12], 2 * BR, DM, (bf16_t*)(ws + WS_W1), 32 * nb, 64 * kb, 32 * nb, P.in[11], scr, lane); continue; } r -= I1;
        if (r < IG) { const int nblk = BR / 32, kb = r / nblk, nb = r % nblk; tr_item(P.in[21], BR, BR, (bf16_t*)(ws + WS_WG), 32 * nb, 64 * kb, 32 * nb, nullptr, scr, lane); continue; } r -= IG;
        { const int nblk = DM / 32, kb = r / nblk, nb = r % nblk; tr_item(P.in[23], DM, BR, (bf16_t*)(ws + WS_WO1), 32 * nb, 64 * kb, 32 * nb, nullptr, scr, lane); }
    }
    const float* x = P.in[0]; const float* g0 = P.in[1]; bf16_t* XN = (bf16_t*)(ws + WS_XN);
    f32x4 gv[4];
#pragma unroll
    for (int j = 0; j < 4; ++j) gv[j] = *((const f32x4*)g0 + lane + 64 * j);
    for (int m0 = gw * 4; m0 < MT; m0 += NGW * 4) {
        f32x4 v[4][4]; float s2[4];
#pragma unroll
        for (int q = 0; q < 4; ++q) { const f32x4* xr = (const f32x4*)(x + (size_t)(m0 + q) * DM) + lane;
#pragma unroll
            for (int j = 0; j < 4; ++j) v[q][j] = __builtin_nontemporal_load(xr + 64 * j); }
#pragma unroll
        for (int q = 0; q < 4; ++q) { float a = 0.f;
#pragma unroll
            for (int j = 0; j < 4; ++j) a += (v[q][j][0] * v[q][j][0] + v[q][j][1] * v[q][j][1]) + (v[q][j][2] * v[q][j][2] + v[q][j][3] * v[q][j][3]);
            s2[q] = a; }
#pragma unroll
        for (int o = 1; o < 64; o <<= 1) {
#pragma unroll
            for (int q = 0; q < 4; ++q) s2[q] += __shfl_xor(s2[q], o); }
#pragma unroll
        for (int q = 0; q < 4; ++q) { const float rs = rsqrtf(s2[q] * (1.f / DM) + EPS);
            unsigned long long* o8 = (unsigned long long*)(XN + (size_t)(m0 + q) * DM) + lane;
#pragma unroll
            for (int j = 0; j < 4; ++j) { const f32x4 w = v[q][j] * rs * gv[j]; o8[64 * j] = (unsigned long long)pk2(w[0], w[1]) | ((unsigned long long)pk2(w[2], w[3]) << 32); } }
    }
    float* rowss = (float*)(ws + WS_MISC + MISC_ROWSS);
    for (int i = gw * 64 + lane; i < MT; i += NGW * 64) rowss[i] = 0.f;
    if (gw == 0 && lane < 8) ((unsigned*)(ws + WS_MISC + 128 * 1024))[64 * lane] = 0u;
    if (gw == 2 && lane < 9) ((unsigned*)(ws + WS_MISC + 160 * 1024))[64 * lane] = 0u;
    if (gw == 1) {
        float* tab = (float*)(ws + WS_MISC + 192 * 1024);
        const float lam = __expf(wave_sum(P.in[5][lane] * P.in[6][lane])) - __expf(wave_sum(P.in[7][lane] * P.in[8][lane])) + LAM0;
        const float SB = 8.f * wave_max(fabsf(P.in[3][lane])) * wave_max(fabsf(P.in[4][lane])) * LOG2E * 1.01f;
        if (lane < 16) { const float s2 = exp2f(-0.5f * (float)(lane + 1)) * LOG2E; tab[lane] = s2; tab[16 + lane] = (2.f * SB + 25.f - log2f(1.f - exp2f(-s2))) / s2; }
        if (lane == 0) { tab[32] = lam; tab[33] = SB; }
    }
}

typedef short bf16x8 __attribute__((ext_vector_type(8)));
typedef short s16x4 __attribute__((ext_vector_type(4)));
typedef float f32x16 __attribute__((ext_vector_type(16)));
typedef unsigned u32x2 __attribute__((ext_vector_type(2)));
constexpr int KROW = 272, VROW = 136, KT_BYTES = 64 * KROW, VT_BYTES = 128 * VROW, AT_VOFF = 2 * KT_BYTES;
constexpr float ATT_THR = 8.f;
typedef float f32x2_t __attribute__((ext_vector_type(2))); typedef __bf16 bf16x2_t __attribute__((ext_vector_type(2)));
__device__ __forceinline__ unsigned cvtpk_s(float lo, float hi) { f32x2_t v = {lo, hi}; bf16x2_t b = __builtin_convertvector(v, bf16x2_t); return __builtin_bit_cast(unsigned, b); }
__device__ __forceinline__ float max3f(float a, float b, float c) { float r; asm("v_max3_f32 %0, %1, %2, %3" : "=v"(r) : "v"(a), "v"(b), "v"(c)); return r; }
__device__ __forceinline__ int crow(int r, int hi) { return (r & 3) + 8 * (r >> 2) + 4 * hi; }

template <int HF>
__device__ __forceinline__ void att_half(f32x16 (&o)[2][4], float (&lsum)[2], const bf16x8 (&qf)[2][4], const LAS unsigned char* kb, const LAS unsigned char* vb,
                                         float slope2, float SB, int kvh0  , int qw0, int r32, int hi, bool band,
                                         bool stage, u32x4 st0, u32x4 st1, LAS unsigned char* sdst  ) {
    u32x4 pw[2][2];
    float s2v = slope2; asm volatile("" : "+v"(s2v));
    const float tb = slope2 * (float)(kvh0 + 4 * hi - qw0 - r32) - SB;
#pragma unroll
    for (int sub = 0; sub < 2; ++sub) {
        f32x16 p;
#pragma unroll
        for (int r = 0; r < 16; ++r) p[r] = __builtin_fmaf(s2v, (float)((r & 3) + 8 * (r >> 2)), tb);
#pragma unroll
        for (int d0 = 0; d0 < 4; ++d0) { const bf16x8 kf = *(const LAS bf16x8*)(kb + HF * 32 * KROW + sub * 128 + d0 * 32);
            p = __builtin_amdgcn_mfma_f32_32x32x16_bf16(kf, qf[sub][d0], p, 0, 0, 0); }
        if (band) { const int lim = qw0 + r32 - (kvh0 + 4 * hi);
            asm volatile("s_nop 15" : "+v"(p));
            const float ninf = -INFINITY;
#pragma unroll
            for (int r = 0; r < 16; ++r) asm("v_cmp_gt_i32_e32 vcc, %2, %1\n\tv_cndmask_b32_e32 %0, %0, %3, vcc" : "+v"(p[r]) : "v"(lim), "i"((r & 3) + 8 * (r >> 2)), "v"(ninf) : "vcc"); }
        float ls = 0.f;
#pragma unroll
        for (int r = 0; r < 16; ++r) { p[r] = __builtin_amdgcn_exp2f(p[r]); ls += p[r]; }
        lsum[sub] += ls;
        pw[sub][0] = (u32x4){cvtpk_s(p[0], p[1]), cvtpk_s(p[2], p[3]), cvtpk_s(p[4], p[5]), cvtpk_s(p[6], p[7])};
        pw[sub][1] = (u32x4){cvtpk_s(p[8], p[9]), cvtpk_s(p[10], p[11]), cvtpk_s(p[12], p[13]), cvtpk_s(p[14], p[15])};
        __builtin_amdgcn_sched_barrier(0);
        if (sub == 0 && stage) {
            if (HF == 0) { *(LAS u32x4*)sdst = st0; *(LAS u32x4*)(sdst + 32 * KROW) = st1; }
            else { *(LAS u32x2*)sdst = (u32x2){st0.x, st0.y}; *(LAS u32x2*)(sdst + 8) = (u32x2){st0.z, st0.w}; *(LAS u32x2*)(sdst + 64 * VROW) = (u32x2){st1.x, st1.y}; *(LAS u32x2*)(sdst + 64 * VROW + 8) = (u32x2){st1.z, st1.w}; }
            __builtin_amdgcn_sched_barrier(0);
        }
    }
#define AT_VFRAG(idx) ({ const LAS unsigned char* va_ = vb + ((idx) & 3) * 32 * VROW + (2 * HF + ((idx) >> 2)) * 32; \
        const s16x4 lo_ = *(const LAS s16x4*)va_, hh_ = *(const LAS s16x4*)(va_ + 16); (bf16x8){lo_[0], lo_[1], lo_[2], lo_[3], hh_[0], hh_[1], hh_[2], hh_[3]}; })
    bf16x8 vcur = AT_VFRAG(0);
    __builtin_amdgcn_s_setprio(1);
#pragma unroll
    for (int idx = 0; idx < 8; ++idx) {
        bf16x8 vnext = vcur;
        if (idx + 1 < 8) vnext = AT_VFRAG(idx + 1);
        const int kk = idx >> 2, d = idx & 3;
        o[0][d] = __builtin_amdgcn_mfma_f32_32x32x16_bf16(vcur, __builtin_bit_cast(bf16x8, pw[0][kk]), o[0][d], 0, 0, 0);
        o[1][d] = __builtin_amdgcn_mfma_f32_32x32x16_bf16(vcur, __builtin_bit_cast(bf16x8, pw[1][kk]), o[1][d], 0, 0, 0);
        __builtin_amdgcn_sched_barrier(0);
        vcur = vnext;
    }
    __builtin_amdgcn_s_setprio(0);
#undef AT_VFRAG
}

__device__ __forceinline__ void attn_unit(int b, int h, int qb, bf16_t* Q, const bf16_t* __restrict__ K, const bf16_t* __restrict__ Vt, const bf16_t* __restrict__ Z, const float* __restrict__ hg, float lam,
                                          LAS unsigned char* lds, int tid, int wave, int lane, int tfirst, float SB, const float* __restrict__ tab, float Dwin) {
    const int r32 = lane & 31, hi = lane >> 5;
    const int q0u = qb * 256, qw0 = q0u + 32 * wave;
    const size_t rowbase = (size_t)b * SEQ;
    const float slope2 = __builtin_bit_cast(float, __builtin_amdgcn_readfirstlane(__builtin_bit_cast(int, tab[h])));
    bf16x8 qf[2][4];
    { const bf16_t* qp = Q + (rowbase + qw0 + r32) * BR + h * 128 + 8 * hi;
#pragma unroll
      for (int sub = 0; sub < 2; ++sub)
#pragma unroll
          for (int d0 = 0; d0 < 4; ++d0) qf[sub][d0] = *(const bf16x8*)(qp + sub * 64 + d0 * 16); }
    const unsigned kgo = (unsigned)(((rowbase + (tid >> 4)) * BR + h * 128 + (tid & 15) * 8) * 2);
    const int kl = (tid >> 4) * KROW + (tid & 15) * 16;
    const unsigned vgo = (unsigned)((((size_t)b * BR + h * 128 + (tid >> 3)) * SEQ + (tid & 7) * 8) * 2);
    const int vl = AT_VOFF + (tid >> 3) * VROW + (tid & 7) * 16;
    const int NT = 4 * (qb + 1), last_w = (qw0 + 31) >> 6;
    int tlo_w = 0; if (Dwin < 4096.f) { const int kmin_w = qw0 - (int)Dwin - 1; tlo_w = kmin_w > 0 ? (kmin_w >> 6) : 0; }
    f32x16 o[2][4];
#pragma unroll
    for (int s = 0; s < 2; ++s)
#pragma unroll
        for (int d = 0; d < 4; ++d)
#pragma unroll
            for (int r = 0; r < 16; ++r) o[s][d][r] = 0.f;
    float lsum[2] = {0.f, 0.f};
    u32x4 ks0, ks1, vs0, vs1;
#define AT_LOADK(tt) do { const unsigned ko = kgo + (unsigned)(tt) * (64 * BR * 2); ks0 = *(const u32x4*)((const char*)K + ko); ks1 = *(const u32x4*)((const char*)K + ko + 32 * BR * 2); } while (0)
#define AT_LOADV(tt) do { const unsigned vo = vgo + (unsigned)(tt) * 128; vs0 = *(const u32x4*)((const char*)Vt + vo); vs1 = *(const u32x4*)((const char*)Vt + vo + 64 * SEQ * 2); } while (0)
#define AT_WRITEK(buf) do { *(LAS u32x4*)(lds + (buf) * KT_BYTES + kl) = ks0; *(LAS u32x4*)(lds + (buf) * KT_BYTES + kl + 32 * KROW) = ks1; } while (0)
#define AT_WRITEV(buf) do { \
        *(LAS u32x2*)(lds + (buf) * VT_BYTES + vl) = (u32x2){vs0.x, vs0.y}; *(LAS u32x2*)(lds + (buf) * VT_BYTES + vl + 8) = (u32x2){vs0.z, vs0.w}; \
        *(LAS u32x2*)(lds + (buf) * VT_BYTES + vl + 64 * VROW) = (u32x2){vs1.x, vs1.y}; *(LAS u32x2*)(lds + (buf) * VT_BYTES + vl + 64 * VROW + 8) = (u32x2){vs1.z, vs1.w}; } while (0)
    AT_LOADK(tfirst); AT_LOADV(tfirst); AT_WRITEK(tfirst & 1); AT_WRITEV(tfirst & 1);
    __syncthreads();
    for (int t = tfirst; t < NT; ++t) {
        const int cur = t & 1; const bool more = (t + 1 < NT), active = (t <= last_w) && (t >= tlo_w), band = (64 * t + 63 > qw0);
        const LAS unsigned char* kb = lds + cur * KT_BYTES + r32 * KROW + hi * 16;
        const LAS unsigned char* vb = lds + AT_VOFF + cur * VT_BYTES + r32 * VROW + hi * 8;
        if (more) AT_LOADK(t + 1);
        __builtin_amdgcn_sched_barrier(0);
        if (active) att_half<0>(o, lsum, qf, kb, vb, slope2, SB, 64 * t, qw0, r32, hi, band, more, ks0, ks1, lds + (cur ^ 1) * KT_BYTES + kl);
        else if (more) AT_WRITEK(cur ^ 1);
        __builtin_amdgcn_sched_barrier(0);
        if (more) AT_LOADV(t + 1);
        __builtin_amdgcn_sched_barrier(0);
        if (active && (64 * t + 32 <= qw0 + 31)) att_half<1>(o, lsum, qf, kb, vb, slope2, SB, 64 * t + 32, qw0, r32, hi, band, more, vs0, vs1, lds + (cur ^ 1) * VT_BYTES + vl);
        else if (more) AT_WRITEV(cur ^ 1);
        __syncthreads();
    }
#undef AT_LOADK
#undef AT_LOADV
#undef AT_WRITEK
#undef AT_WRITEV
    const float l1 = lsum[0] + __shfl_xor(lsum[0], 32), l2 = lsum[1] + __shfl_xor(lsum[1], 32);
    const float i1 = 1.f / l1, i2 = lam / l2;
    float ss = 0.f;
#pragma unroll
    for (int d = 0; d < 4; ++d)
#pragma unroll
        for (int r = 0; r < 16; ++r) { const float v = o[0][d][r] * i1 - o[1][d][r] * i2; o[0][d][r] = v; ss += v * v; }
    ss += __shfl_xor(ss, 32);
    const float rs = rsqrtf(ss * (1.f / 128.f) + EPS) * (1.f - LAM0);
    int lane_l = lane; asm volatile("" : "+v"(lane_l));
    const size_t off = (rowbase + qw0 + (lane_l & 31)) * BR + h * 128 + 4 * (lane_l >> 5);
    __builtin_amdgcn_sched_barrier(0);
    const int hi_l = lane_l >> 5;
    const size_t offw = off - 4 * hi_l;
#pragma unroll
    for (int d = 0; d < 4; ++d)
#pragma unroll
        for (int ip = 0; ip < 2; ++ip) { __builtin_amdgcn_sched_barrier(0);
            u32x2 w[2];
#pragma unroll
            for (int k = 0; k < 2; ++k) { const int i = 2 * ip + k, e = 32 * d + 8 * i;
                const f32x4 g4 = *(const f32x4*)(hg + e + 4 * hi_l); const u32x2 z2 = *(const u32x2*)(Z + off + e);
                const float v0 = o[0][d][4 * i] * rs * g4[0] * siluf_(bflo(z2.x)), v1 = o[0][d][4 * i + 1] * rs * g4[1] * siluf_(bfhi(z2.x));
                const float v2 = o[0][d][4 * i + 2] * rs * g4[2] * siluf_(bflo(z2.y)), v3 = o[0][d][4 * i + 3] * rs * g4[3] * siluf_(bfhi(z2.y));
                w[k] = (u32x2){pk2(v0, v1), pk2(v2, v3)}; }
            const u32x2 snd = hi_l ? w[0] : w[1];
            const unsigned rx = __shfl_xor(snd.x, 32), ry = __shfl_xor(snd.y, 32);
            const u32x4 st = hi_l ? (u32x4){rx, ry, w[1].x, w[1].y} : (u32x4){w[0].x, w[0].y, rx, ry};
            *(u32x4*)(Q + offw + 32 * d + 16 * ip + 8 * hi_l) = st; }
}
constexpr size_t MISC_ATQ = 128 * 1024, MISC_ATT = 192 * 1024;
__device__ __forceinline__ void attn_phase(const Params& P, LAS unsigned char* lds, int bx, int tid_in) {
    int tid = tid_in; asm volatile("" : "+v"(tid)); const int lane = tid & 63, wave = __builtin_amdgcn_readfirstlane(tid >> 6);
    unsigned char* ws = P.ws;
    bf16_t* Q = (bf16_t*)(ws + WS_Q); const bf16_t* K = (const bf16_t*)(ws + WS_K); const bf16_t* Vt = (const bf16_t*)(ws + WS_V); const bf16_t* Z = (const bf16_t*)P.out;
    const float* tab = (const float*)(ws + WS_MISC + MISC_ATT);
    const float lam = __builtin_bit_cast(float, __builtin_amdgcn_readfirstlane(__builtin_bit_cast(int, tab[32]))), SB = __builtin_bit_cast(float, __builtin_amdgcn_readfirstlane(__builtin_bit_cast(int, tab[33])));
    unsigned* qctr = (unsigned*)(ws + WS_MISC + MISC_ATQ) + 64 * (bx & 7);
    volatile LAS int* slot = (volatile LAS int*)(lds + 2 * KT_BYTES + 2 * VT_BYTES);
    const int b = bx & 7;
    int unext = 0; if (tid == 0) unext = (int)atomicAdd(qctr, 1u);
    for (;;) {
        if (tid == 0) *slot = unext;
        __syncthreads();
        const int u = __builtin_amdgcn_readfirstlane(*slot);
        __syncthreads();
        if (u >= 256) break;
        if (tid == 0) unext = (int)atomicAdd(qctr, 1u);
        const int h = 15 - (u >> 4), qb = 15 - (u & 15);
        const float Df = tab[16 + h];
        int tfirst = 0;
        if (Df < 4096.f) { const int kmin = qb * 256 - (int)Df - 1; tfirst = kmin > 0 ? (kmin >> 6) : 0; }
        tfirst = __builtin_amdgcn_readfirstlane(tfirst);
        attn_unit(b, h, qb, Q, K, Vt, Z, P.in[9], lam, lds, tid, wave, lane, tfirst, SB, tab, Df);
    }
}
constexpr size_t MISC_AB = 256 * 1024, MISC_BBT = 512 * 1024, MISC_CMT = 1024 * 1024 + 512 * 1024;
constexpr int HROW = 272;
__device__ __forceinline__ void s5_tables(const Params& P, int gw, int NGW, int lane) {
    unsigned char* ws = P.ws;
    float* AB = (float*)(ws + WS_MISC + MISC_AB); bf16_t* BBT = (bf16_t*)(ws + WS_MISC + MISC_BBT); bf16_t* CMT = (bf16_t*)(ws + WS_MISC + MISC_CMT);
    for (int g = gw; g < 128; g += NGW) {
        const int p = lane;
        const float dt = __expf(P.in[15][g]), lr = P.in[13][g * 64 + p], li = P.in[14][g * 64 + p];
        const float mag = __expf(lr * dt), ar = mag * cosf(li * dt), ai = mag * sinf(li * dt);
        const float den = lr * lr + li * li, nr = ar - 1.f, ni = ai, gr = (nr * lr + ni * li) / den, gi = (ni * lr - nr * li) / den;
        AB[(g * 64 + p) * 2] = ar; AB[(g * 64 + p) * 2 + 1] = ai;
        const int jre = p >> 5, n = p & 31;
#pragma unroll
        for (int c = 0; c < 16; ++c) { const float br = P.in[16][(g * 64 + p) * 16 + c], bi = P.in[17][(g * 64 + p) * 16 + c];
            BBT[((g * 4 + jre) * 32 + n) * 16 + c] = (bf16_t)f2bf(gr * br - gi * bi); BBT[((g * 4 + 2 + jre) * 32 + n) * 16 + c] = (bf16_t)f2bf(gr * bi + gi * br);
            CMT[(g * 16 + c) * 128 + 2 * p] = (bf16_t)f2bf(P.in[18][(g * 16 + c) * 64 + p]); CMT[(g * 16 + c) * 128 + 2 * p + 1] = (bf16_t)f2bf(-P.in[19][(g * 16 + c) * 64 + p]); }
    }
}
constexpr size_t MISC_SEG = 4 * 1024 * 1024;
constexpr int S5_SEGLEN = 512;
template <bool FULL>
__device__ __forceinline__ void s5_pass(const Params& P, LAS unsigned char* lds, int bx, int tid_in) {
    int tid = tid_in; asm volatile("" : "+v"(tid)); const int lane = tid & 63, wave = __builtin_amdgcn_readfirstlane(tid >> 6);
    unsigned char* ws = P.ws;
    const bf16_t* U = (const bf16_t*)(ws + WS_Q); bf16_t* YG = (bf16_t*)(ws + WS_V);
    const float* AB = (const float*)(ws + WS_MISC + MISC_AB); const bf16_t* BBT = (const bf16_t*)(ws + WS_MISC + MISC_BBT); const bf16_t* CMT = (const bf16_t*)(ws + WS_MISC + MISC_CMT);
    f32x4* SEG = (f32x4*)(ws + WS_MISC + MISC_SEG);
    LAS unsigned char* hl = lds + wave * (32 * HROW);
    const int r32 = lane & 31, hi = lane >> 5, l16 = lane & 15, kg = lane >> 4;
    for (int task = bx * NWAVES + wave; task < 4096; task += NWAVES * (int)gridDim.x) {
        const int g = task & 127, bp = (task >> 7) & 3, seg = task >> 9;
        if (!FULL && seg == 7) continue;
        const float ar0 = AB[(g * 64 + r32) * 2], ai0 = AB[(g * 64 + r32) * 2 + 1], ar1 = AB[(g * 64 + 32 + r32) * 2], ai1 = AB[(g * 64 + 32 + r32) * 2 + 1];
        bf16x8 bfr[4], cfr[4];
#pragma unroll
        for (int j = 0; j < 4; ++j) { bfr[j] = *(const bf16x8*)(BBT + ((g * 4 + j) * 32 + r32) * 16 + 8 * hi); if (FULL) cfr[j] = *(const bf16x8*)(CMT + (g * 16 + l16) * 128 + 32 * j + 8 * kg); }
        bf16x8 dh, dl;
        if (FULL) { const float d = P.in[20][g * 16 + l16]; const unsigned h16 = f2bf(d); const unsigned l16b = f2bf(d - __builtin_bit_cast(float, h16 << 16));
#pragma unroll
          for (int i = 0; i < 8; ++i) { const bool on = (kg < 2) && (8 * kg + i == l16); dh[i] = on ? (short)h16 : (short)0; dl[i] = on ? (short)l16b : (short)0; } }
        const int m = r32, bsel = (m >> 2) & 1, tok = (m & 3) + 4 * (m >> 3);
        const int tbeg = seg * S5_SEGLEN;
        const bf16_t* u32p = U + ((size_t)(bp + 4 * bsel) * SEQ + tbeg + tok) * BR + g * 16 + 8 * hi;
        const bf16_t* u16p = U + ((size_t)bp * SEQ + tbeg + l16) * BR + g * 16 + 8 * (kg & 1);
        bf16_t* yp = YG + ((size_t)bp * SEQ + tbeg + 4 * kg) * BR + g * 16 + l16;
        float h0r = 0.f, h0i = 0.f, h1r = 0.f, h1i = 0.f;
        if (FULL && seg > 0) {
            float p0r = ar0, p0i = ai0, p1r = ar1, p1i = ai1;
#pragma unroll
            for (int q = 0; q < 9; ++q) { const float a = p0r * p0r - p0i * p0i, b2 = 2.f * p0r * p0i, c = p1r * p1r - p1i * p1i, d2 = 2.f * p1r * p1i; p0r = a; p0i = b2; p1r = c; p1i = d2; }
            for (int j = 0; j < seg; ++j) { const f32x4 e = SEG[(size_t)(task - (seg - j) * 512) * 64 + lane];
                const float n0r = p0r * h0r - p0i * h0i + e[0], n0i = p0r * h0i + p0i * h0r + e[1], n1r = p1r * h1r - p1i * h1i + e[2], n1i = p1r * h1i + p1i * h1r + e[3];
                h0r = n0r; h0i = n0i; h1r = n1r; h1i = n1i; }
        }
        bf16x8 ua = *(const bf16x8*)u32p, ub0, ub1;
        if (FULL) { ub0 = *(const bf16x8*)u16p; ub1 = *(const bf16x8*)(u16p + (size_t)4 * SEQ * BR); }
        for (int t0 = 0; t0 < S5_SEGLEN; t0 += 16) {
            const bf16x8 ca = ua; bf16x8 cb0, cb1; if (FULL) { cb0 = ub0; cb1 = ub1; }
            if (t0 + 16 < S5_SEGLEN) { const size_t o = (size_t)(t0 + 16) * BR; ua = *(const bf16x8*)(u32p + o); if (FULL) { ub0 = *(const bf16x8*)(u16p + o); ub1 = *(const bf16x8*)(u16p + o + (size_t)4 * SEQ * BR); } }
            if (FULL && kg >= 2) { cb0 = (bf16x8){0, 0, 0, 0, 0, 0, 0, 0}; cb1 = cb0; }
            f32x16 acc[4];
#pragma unroll
            for (int j = 0; j < 4; ++j) {
#pragma unroll
                for (int r = 0; r < 16; ++r) acc[j][r] = 0.f;
                acc[j] = __builtin_amdgcn_mfma_f32_32x32x16_bf16(ca, bfr[j], acc[j], 0, 0, 0); }
#pragma unroll
            for (int r = 0; r < 16; ++r) {
                const float n0r = ar0 * h0r - ai0 * h0i + acc[0][r], n0i = ar0 * h0i + ai0 * h0r + acc[2][r];
                const float n1r = ar1 * h1r - ai1 * h1i + acc[1][r], n1i = ar1 * h1i + ai1 * h1r + acc[3][r];
                h0r = n0r; h0i = n0i; h1r = n1r; h1i = n1i;
                if (FULL) { *(LAS unsigned*)(hl + (16 * hi + r) * HROW + r32 * 4) = cvtpk_s(n0r, n0i);
                    *(LAS unsigned*)(hl + (16 * hi + r) * HROW + (32 + r32) * 4) = cvtpk_s(n1r, n1i); }
            }
            if (FULL) {
#pragma unroll
            for (int blk = 0; blk < 2; ++blk) {
                f32x4 y = (f32x4){0.f, 0.f, 0.f, 0.f};
#pragma unroll
                for (int kk = 0; kk < 4; ++kk) { const bf16x8 hf = *(const LAS bf16x8*)(hl + (16 * blk + l16) * HROW + kk * 64 + kg * 16);
                    y = __builtin_amdgcn_mfma_f32_16x16x32_bf16(hf, cfr[kk], y, 0, 0, 0); }
                y = __builtin_amdgcn_mfma_f32_16x16x32_bf16(blk ? cb1 : cb0, dh, y, 0, 0, 0);
                y = __builtin_amdgcn_mfma_f32_16x16x32_bf16(blk ? cb1 : cb0, dl, y, 0, 0, 0);
                bf16_t* o = yp + ((size_t)(4 * blk) * SEQ + t0) * BR;
                const unsigned w01 = cvtpk_s(gelu_tanh(y[0]), gelu_tanh(y[1])), w23 = cvtpk_s(gelu_tanh(y[2]), gelu_tanh(y[3]));
                o[0] = (bf16_t)(w01 & 0xffffu); o[(size_t)BR] = (bf16_t)(w01 >> 16); o[(size_t)2 * BR] = (bf16_t)(w23 & 0xffffu); o[(size_t)3 * BR] = (bf16_t)(w23 >> 16);
            }
            }
        }
        if (!FULL) SEG[(size_t)task * 64 + lane] = (f32x4){h0r, h0i, h1r, h1i};
    }
}
__global__ void __launch_bounds__(NTHREADS, 2) fwd_mega(Params P) {
    extern __shared__ __attribute__((aligned(16))) unsigned char lds_raw[];
    LAS unsigned char* lds = (LAS unsigned char*)lds_raw;
    const int G = gridDim.x, bx = blockIdx.x, NGW = G * NWAVES;
    const int wave_s = __builtin_amdgcn_readfirstlane((int)threadIdx.x >> 6);
    unsigned* gbar_base = (unsigned*)(P.ws + WS_MISC + 160 * 1024); unsigned gbar_k = 0;
    const unsigned gbar_ng = G < 8 ? (unsigned)G : 8u, gbar_nx = (unsigned)(G - (bx & 7) + 7) >> 3;
#define GRID_BAR() do { ++gbar_k; __syncthreads(); if (MYTID == 0) { __threadfence(); \
        if (atomicAdd(gbar_base + 64 * (bx & 7), 1u) == gbar_k * gbar_nx - 1u) atomicAdd(gbar_base + 64 * 8, 1u); \
        while (__hip_atomic_load(gbar_base + 64 * 8, __ATOMIC_RELAXED, __HIP_MEMORY_SCOPE_AGENT) < gbar_k * gbar_ng) __builtin_amdgcn_s_sleep(1); \
        __threadfence(); } __syncthreads(); } while (0)
#define MYTID (wave_s * 64 + (int)__builtin_amdgcn_mbcnt_hi(~0u, __builtin_amdgcn_mbcnt_lo(~0u, 0u)))
#define PHASE_IDS int tid = MYTID; asm volatile("" : "+v"(tid)); const int lane = tid & 63, wave = __builtin_amdgcn_readfirstlane(tid >> 6), gw = bx * NWAVES + wave; (void)gw; (void)lane
    unsigned char* ws = P.ws;
    bf16_t* XN = (bf16_t*)(ws + WS_XN); bf16_t* Qb = (bf16_t*)(ws + WS_Q); bf16_t* Kb = (bf16_t*)(ws + WS_K); bf16_t* Vb = (bf16_t*)(ws + WS_V);
    float* rowss = (float*)(ws + WS_MISC + MISC_ROWSS);

    { PHASE_IDS; prologue(P, lds, gw, NGW, wave, lane); s5_tables(P, gw, NGW, lane); }
    cg::this_grid().sync();
    {
        {
            pg8::Gemm g{XN, (const bf16_t*)(ws + WS_W0), MT, 4096, DM}; pg8::StaticOrder S; S.init(MT, 4096, G, bx);
            EpiQKZ E{Qb, Kb, (bf16_t*)P.out, P.in[3], P.in[4], 0};
            pg8::gemm_phase<EpiQKZ, pg8::StaticOrder, true, true>(lds, g, S, E, MYTID);
            pg8::Gemm gz{XN, (const bf16_t*)(ws + WS_W0) + (size_t)4096 * DM, MT, 2048, DM}; pg8::StaticOrder Sz; Sz.init(MT, 2048, G, bx);
            EpiQKZ Ez{Qb, Kb, (bf16_t*)P.out, P.in[3], P.in[4], 16};
            pg8::gemm_phase<EpiQKZ, pg8::StaticOrder, true, true>(lds, gz, Sz, Ez, MYTID);
        }
        pg8::Gemm g2{(const bf16_t*)(ws + WS_W0) + (size_t)6144 * DM, XN, BR, MT, DM}; pg8::StaticOrder S2; S2.init(BR, MT, G, bx);
        EpiVt E2{Vb};
        pg8::gemm_phase<EpiVt, pg8::StaticOrder, true, true>(lds, g2, S2, E2, MYTID);
    }
    GRID_BAR();
    attn_phase(P, lds, bx, MYTID);
    GRID_BAR();
    {
        pg8::Gemm g{Qb, (const bf16_t*)(ws + WS_WO0), MT, DM, BR}; pg8::StaticOrder S; S.init(MT, DM, G, bx);
        EpiWo0 E{P.in[0], P.out, XN, rowss};
        pg8::gemm_phase<EpiWo0, pg8::StaticOrder, true, true>(lds, g, S, E, MYTID);
    }
    GRID_BAR();
    {
        pg8::Gemm g{XN, (const bf16_t*)(ws + WS_W1), MT, 2 * BR, DM}; pg8::StaticOrder S; S.init(MT, 2 * BR, G, bx);
        EpiUZ E{Qb, Kb, rowss};
        pg8::gemm_phase<EpiUZ, pg8::StaticOrder, true, true>(lds, g, S, E, MYTID);
    }
    GRID_BAR();
    s5_pass<false>(P, lds, bx, MYTID);
    GRID_BAR();
    s5_pass<true>(P, lds, bx, MYTID);
    GRID_BAR();
    {
        pg8::Gemm g{Vb, (const bf16_t*)(ws + WS_WG), MT, BR, BR}; pg8::StaticOrder S; S.init(MT, BR, G, bx);
        EpiGLU E{Vb, Kb, Qb, P.in[22]};
        pg8::gemm_phase<EpiGLU, pg8::StaticOrder, true, true>(lds, g, S, E, MYTID);
    }
    GRID_BAR();
    {
        pg8::Gemm g{Qb, (const bf16_t*)(ws + WS_WO1), MT, DM, BR}; pg8::StaticOrder S; S.init(MT, DM, G, bx);
        EpiOut E{P.out, XN};
        pg8::gemm_phase<EpiOut, pg8::StaticOrder, true, true>(lds, g, S, E, MYTID);
    }
}

extern "C" void kernel_launch(void* const* d_in, const int* in_sizes, int n_in, void* d_out, int out_size, void* d_ws, size_t ws_size, hipStream_t stream) {
    static int grid = 0;
    if (grid == 0) {
        if (n_in != 24 || out_size != MT * DM || ws_size < WS_END) { fprintf(stderr, "kernel_launch: unexpected shapes n_in %d out %d ws %zu\n", n_in, out_size, ws_size); grid = -1; return; }
        int dev = 0, cus = 0, per_cu = 0;
        hipGetDevice(&dev); hipDeviceGetAttribute(&cus, hipDeviceAttributeMultiprocessorCount, dev);
        if (hipFuncSetAttribute((const void*)fwd_mega, hipFuncAttributeMaxDynamicSharedMemorySize, LDS_BYTES) != hipSuccess) { fprintf(stderr, "kernel_launch: hipFuncSetAttribute failed\n"); grid = -1; return; }
        if (hipOccupancyMaxActiveBlocksPerMultiprocessor(&per_cu, (const void*)fwd_mega, NTHREADS, LDS_BYTES) != hipSuccess || per_cu < 1) { fprintf(stderr, "kernel_launch: occupancy query says %d\n", per_cu); grid = -1; return; }
        grid = cus;
    }
    if (grid < 0) return;
    Params p{};
    for (int i = 0; i < 24; ++i) p.in[i] = (const float*)d_in[i];
    p.out = (float*)d_out; p.ws = (unsigned char*)d_ws;
    void* args[] = {&p};
    hipError_t e = hipLaunchCooperativeKernel((const void*)fwd_mega, dim3(grid), dim3(NTHREADS), args, LDS_BYTES, stream);
    if (e != hipSuccess) fprintf(stderr, "cooperative launch failed: %s (grid %d)\n", hipGetErrorString(e), grid);

}
```
